# Optimizing an MI355X kernel written in HIP

```python
import jax, jax.numpy as jnp
from jax import lax
import numpy as np

D_MODEL = 2048
BATCH = 16
SEQ = 256
DEPTH = 1
DEC_BATCH = 4
DEC_SEQ = 1024
PAST_LEN = 512

GRID_W = 64
HEAD_SIZE = 64
D_A = 2048
N_HEADS_A = D_A // HEAD_SIZE
D_B = 2048
R_DECAY = 96
R_ICLR = 96
N_DIR = 2
RMS_EPS = 1e-6
GN_EPS = HEAD_SIZE * 1e-5
N_SHIFTED = 3 * D_A + N_DIR * (R_DECAY + R_ICLR)
D_IN = N_SHIFTED + D_A + 4 * D_B + 2 * D_MODEL

kernel_name = "hybrid_rwkv7_shortconv_diffusion_step"


def _rmsnorm(x, g):
    xf = x.astype(jnp.float32)
    xf = xf * lax.rsqrt(jnp.mean(xf * xf, axis=-1, keepdims=True) + RMS_EPS)
    return (xf * g.astype(jnp.float32)).astype(x.dtype)


def _token_shift(z, mu_prev, mu_next):
    zp = jnp.pad(z[:, :-1], ((0, 0), (1, 0), (0, 0)))
    zn = jnp.pad(z[:, 1:], ((0, 0), (0, 1), (0, 0)))
    return z + mu_prev * (zp - z) + mu_next * (zn - z)


def _conv3_rows(u, w, rows):
    b, t, ch = u.shape
    ur = u.reshape(b, rows, t // rows, ch)
    up = jnp.pad(ur, ((0, 0), (0, 0), (1, 1), (0, 0)))
    out = w[0] * up[:, :, :-2] + w[1] * up[:, :, 1:-1] + w[2] * up[:, :, 2:]
    return out.reshape(b, t, ch)


def _heads(u):
    return u.reshape(u.shape[:-1] + (N_HEADS_A, HEAD_SIZE))


def _wkv_bidir(S0, r, decay, k, v, a_vec, b_vec):
    def orient(t):
        return jnp.stack([t[0], jnp.flip(t[1], axis=1)], axis=0)

    xs = tuple(jnp.moveaxis(orient(t), 2, 0) for t in (r, decay, k, v, a_vec, b_vec))

    def step(S, inp):
        r_t, w_t, k_t, v_t, a_t, b_t = inp
        sa = jnp.einsum('dbhij,dbhj->dbhi', S, a_t)
        S = S * w_t[..., None, :] + sa[..., :, None] * b_t[..., None, :] + v_t[..., :, None] * k_t[..., None, :]
        y = jnp.einsum('dbhij,dbhj->dbhi', S, r_t)
        return S, y

    S_fin, ys = lax.scan(step, S0, xs)
    return S_fin, orient(jnp.moveaxis(ys, 0, 2))


def _mixer(h, S0, rows, w_in, mu_prev, mu_next, w0, w2, a0, a2, k_k, k_a, r_k, lnx_g, lnx_b,
           conv_w, w_out_a, w_out_b, w_o):
    f32 = jnp.float32
    bsz, t, _ = h.shape
    z = h @ w_in
    zs = _token_shift(z[..., :N_SHIFTED], mu_prev, mu_next).astype(f32)
    r = zs[..., :D_A]
    k = zs[..., D_A:2 * D_A]
    v = zs[..., 2 * D_A:3 * D_A]
    o_w = 3 * D_A + N_DIR * R_DECAY
    wd = zs[..., 3 * D_A:o_w].reshape(bsz, t, N_DIR, R_DECAY)
    ad = zs[..., o_w:].reshape(bsz, t, N_DIR, R_ICLR)
    g_a, b_gate, c_gate, x_b, g_b, m_a, m_b = jnp.split(
        z[..., N_SHIFTED:],
        [D_A, D_A + D_B, D_A + 2 * D_B, D_A + 3 * D_B, D_A + 4 * D_B, D_A + 4 * D_B + D_MODEL], axis=-1)

    w_lin = w0[:, None, None, :] + jnp.einsum('btdr,drc->dbtc', jnp.tanh(wd), w2)
    decay = jnp.exp(-jnp.exp(-jax.nn.softplus(-w_lin) - 0.5))
    a = jax.nn.sigmoid(a0[:, None, None, :] + jnp.einsum('btdr,drc->dbtc', ad, a2))
    kk = _heads(k * k_k)
    kk = kk / jnp.maximum(jnp.sqrt(jnp.sum(kk * kk, axis=-1, keepdims=True)), 1e-12)
    kk = kk.reshape(bsz, t, D_A)
    k_dir = k[None] * (1.0 + (a - 1.0) * k_a)
    r2 = jnp.broadcast_to(r[None], (N_DIR,) + r.shape)
    v2 = jnp.broadcast_to(v[None], (N_DIR,) + v.shape)
    kk2 = jnp.broadcast_to(kk[None], (N_DIR,) + kk.shape)
    S_fin, ys = _wkv_bidir(S0, _heads(r2), _heads(decay), _heads(k_dir), _heads(v2),
                           _heads(-kk2), _heads(kk2 * a))
    y = ys[0] + ys[1]
    mu = jnp.mean(y, axis=-1, keepdims=True)
    var = jnp.mean(jnp.square(y - mu), axis=-1, keepdims=True)
    y = ((y - mu) * lax.rsqrt(var + GN_EPS)).reshape(bsz, t, D_A) * lnx_g + lnx_b
    bonus = jnp.sum(_heads(r2 * k_dir) * r_k, axis=-1, keepdims=True) * _heads(v2)
    y = y + jnp.sum(bonus, axis=0).reshape(bsz, t, D_A)
    y_a = (y.astype(h.dtype) * jax.nn.silu(g_a)) @ w_out_a

    u = _conv3_rows(c_gate * x_b, conv_w, rows)
    y_b = (b_gate * u * jax.nn.silu(g_b)) @ w_out_b

    merged = jax.nn.sigmoid(m_a) * y_a + jax.nn.sigmoid(m_b) * y_b
    return merged @ w_o, S_fin


def _block(x, mod, S0, rows, norm_g, *mixer_w):
    shift, scale, gate = jnp.split(mod, 3, axis=-1)
    h = _rmsnorm(x, norm_g) * (1.0 + scale) + shift
    out, S_fin = _mixer(h, S0, rows, *mixer_w)
    return x + gate * out, S_fin


def setup_inputs(seed: int = 0) -> dict:
    key = jax.random.key(seed)
    ks = jax.random.split(key, 26)
    f32 = jnp.float32

    def nrm(k, shape, s):
        return s * jax.random.normal(k, shape, f32)

    def uni(k, shape, lo, hi):
        return jax.random.uniform(k, shape, f32, lo, hi)

    L, H, N = DEPTH, N_HEADS_A, HEAD_SIZE
    return {
        "x_prompt": nrm(ks[0], (BATCH, SEQ, D_MODEL), 1.0),
        "x_sample": nrm(ks[1], (DEC_BATCH, DEC_SEQ, D_MODEL), 1.0),
        "state_wkv_fwd": nrm(ks[2], (DEC_BATCH, L, H, N, N), 0.5),
        "state_wkv_bwd": nrm(ks[3], (DEC_BATCH, L, H, N, N), 0.5),
        "c": nrm(ks[4], (DEC_BATCH, D_MODEL), 1.0),
        "c_ctx": nrm(ks[5], (D_MODEL,), 1.0),
        "ada_w": nrm(ks[6], (L, D_MODEL, 3 * D_MODEL), 0.5 * D_MODEL ** -0.5),
        "ada_b": nrm(ks[7], (L, 3 * D_MODEL), 0.02),
        "norm_g": 1.0 + nrm(ks[8], (L, D_MODEL), 0.02),
        "w_in": nrm(ks[9], (L, D_MODEL, D_IN), D_MODEL ** -0.5),
        "mu_prev": uni(ks[10], (L, N_SHIFTED), 0.0, 0.5),
        "mu_next": uni(ks[11], (L, N_SHIFTED), 0.0, 0.5),
        "w0": uni(ks[12], (L, N_DIR, D_A), -4.0, -0.5),
        "w2": nrm(ks[13], (L, N_DIR, R_DECAY, D_A), 0.3 * R_DECAY ** -0.5),
        "a0": nrm(ks[14], (L, N_DIR, D_A), 0.1),
        "a2": nrm(ks[15], (L, N_DIR, R_ICLR, D_A), R_ICLR ** -0.5),
        "k_k": 0.85 + nrm(ks[16], (L, D_A), 0.05),
        "k_a": 1.0 + nrm(ks[17], (L, D_A), 0.05),
        "r_k": nrm(ks[18], (L, H, N), 0.1),
        "lnx_g": 1.0 + nrm(ks[19], (L, D_A), 0.02),
        "lnx_b": nrm(ks[20], (L, D_A), 0.01),
        "conv_w": nrm(ks[21], (L, 3, D_B), 3 ** -0.5),
        "w_out_a": nrm(ks[22], (L, D_A, D_MODEL), D_A ** -0.5),
        "w_out_b": nrm(ks[23], (L, D_B, D_MODEL), D_B ** -0.5),
        "w_o": nrm(ks[24], (L, D_MODEL, D_MODEL), D_MODEL ** -0.5),
        "final_g": 1.0 + nrm(ks[25], (D_MODEL,), 0.02),
    }


def reference(x_prompt, x_sample, state_wkv_fwd, state_wkv_bwd, c, c_ctx, ada_w, ada_b, norm_g, w_in,
              mu_prev, mu_next, w0, w2, a0, a2, k_k, k_a, r_k, lnx_g, lnx_b, conv_w, w_out_a, w_out_b,
              w_o, final_g):
    f32 = jnp.float32
    n_ctx_batch = x_prompt.shape[0]
    lat_rows = x_sample.shape[1] // GRID_W
    xp = x_prompt
    xl = x_sample
    fwd_states = []
    bwd_states = []
    for l in range(DEPTH):
        lw = (norm_g[l], w_in[l], mu_prev[l], mu_next[l], w0[l], w2[l], a0[l], a2[l], k_k[l], k_a[l],
              r_k[l], lnx_g[l], lnx_b[l], conv_w[l], w_out_a[l], w_out_b[l], w_o[l])
        mod_ctx = (jax.nn.silu(c_ctx) @ ada_w[l] + ada_b[l])[None, None, :]
        mod_lat = (jax.nn.silu(c) @ ada_w[l] + ada_b[l])[:, None, :]
        S0_ctx = jnp.zeros((N_DIR, n_ctx_batch, N_HEADS_A, HEAD_SIZE, HEAD_SIZE), f32)
        xp, S_ctx = _block(xp, mod_ctx, S0_ctx, 1, *lw)
        fwd_states.append(S_ctx[0])
        bwd_states.append(S_ctx[1])
        S0_lat = jnp.stack([state_wkv_fwd[:, l], state_wkv_bwd[:, l]], axis=0).astype(f32)
        xl, _ = _block(xl, mod_lat, S0_lat, lat_rows, *lw)
    y_prompt = _rmsnorm(xp, final_g)
    y_sample = _rmsnorm(xl, final_g)
    new_state_wkv_fwd = jnp.stack(fwd_states, axis=1).astype(x_prompt.dtype)
    new_state_wkv_bwd = jnp.stack(bwd_states, axis=1).astype(x_prompt.dtype)
    return (y_prompt, y_sample, new_state_wkv_fwd, new_state_wkv_bwd)
```

```cpp
#include <hip/hip_runtime.h>
#include <hip/hip_cooperative_groups.h>
#include <hip/hip_fp16.h>
#include <cstdio>
#include <cstdint>
namespace cg = cooperative_groups;

#define LAS __attribute__((address_space(3)))
typedef unsigned short bf16_t;
typedef short bf16x8 __attribute__((ext_vector_type(8)));
typedef float f32x4 __attribute__((ext_vector_type(4)));
typedef float f32x2 __attribute__((ext_vector_type(2)));
typedef unsigned u32x4 __attribute__((ext_vector_type(4)));
typedef unsigned u32x2 __attribute__((ext_vector_type(2)));

#ifndef EXP_CTX
#define EXP_CTX 1
#endif
#ifndef EXP_LAT
#define EXP_LAT 1
#endif
#ifndef EXP_ST
#define EXP_ST 1
#endif
#ifndef PH_HI
#define PH_HI NPHASE
#endif
#ifndef N_LAUNCH_SPLIT
#define N_LAUNCH_SPLIT 0
#endif

constexpr int D = 2048, NTOK = 8192, NCTX = 4096, DIN = 20864, NPAD = 20992, NSH = 6528;
constexpr int NPHASE = 9;
constexpr size_t GS = (size_t)NTOK * D;
constexpr size_t OFF_WINT = 0;
constexpr size_t SZ_WINT = (size_t)NPAD * D * 2;
constexpr size_t OFF_WABT = OFF_WINT + SZ_WINT;
constexpr size_t OFF_WOT = OFF_WABT + (size_t)4096 * D * 2;
constexpr size_t OFF_LT = OFF_WOT + (size_t)D * D * 2;
constexpr size_t OFF_MODP = OFF_LT + (size_t)4 * D * 96 * 2;
constexpr size_t OFF_MODG = OFF_MODP + (size_t)16 * 5 * 6144 * 4;
constexpr size_t OFF_BS = OFF_MODG + (size_t)5 * 2048 * 4;
constexpr size_t OFF_H = OFF_BS + (size_t)2 * NTOK * 32 * 4;
constexpr size_t OFF_ZR = OFF_H + GS * 2;
constexpr size_t OFF_ZWD = OFF_ZR + 3 * GS * 2;
constexpr size_t OFF_ZG = OFF_ZWD + (size_t)NTOK * 512 * 2;
constexpr size_t OFF_LAM = OFF_ZG + 7 * GS * 2;
constexpr size_t OFF_PSLOT = OFF_LAM + 4 * GS * 2;
constexpr size_t WS_END = OFF_PSLOT + 1024 * 256;
constexpr size_t OFF_YDIR = OFF_ZG + 1 * GS * 2;

struct Params {
    const float *xp, *xs, *st_f, *st_b, *c, *c_ctx, *ada_w, *ada_b, *norm_g, *w_in, *mu_prev, *mu_next, *w0, *w2, *a0, *a2, *k_k, *k_a, *r_k, *lnx_g, *lnx_b, *conv_w, *w_out_a, *w_out_b, *w_o, *final_g;
    float* out; unsigned char* ws;
    int ph_lo, ph_hi;
};

__device__ __forceinline__ unsigned pk2(float lo, float hi) { unsigned r; asm("v_cvt_pk_bf16_f32 %0, %1, %2" : "=v"(r) : "v"(lo), "v"(hi)); return r; }
__device__ __forceinline__ float bflo(unsigned u) { return __uint_as_float(u << 16); }
__device__ __forceinline__ float bfhi(unsigned u) { return __uint_as_float(u & 0xffff0000u); }
__device__ __forceinline__ float bf1(bf16_t u) { return __uint_as_float(((unsigned)u) << 16); }
__device__ __forceinline__ float sigm(float x) { return 1.f / (1.f + __expf(-x)); }
__device__ __forceinline__ float wave_sum(float v) {
#pragma unroll
    for (int o = 1; o < 64; o <<= 1) v += __shfl_xor(v, o);
    return v;
}
__device__ __forceinline__ float quad_sum(float v) {
    v += __int_as_float(__builtin_amdgcn_update_dpp(0, __float_as_int(v), 0xB1, 0xF, 0xF, true));
    v += __int_as_float(__builtin_amdgcn_update_dpp(0, __float_as_int(v), 0x4E, 0xF, 0xF, true));
    return v;
}
__device__ __forceinline__ void unpack8(const u32x4 u, float (&f)[8]) {
    f[0] = bflo(u.x); f[1] = bfhi(u.x); f[2] = bflo(u.y); f[3] = bfhi(u.y); f[4] = bflo(u.z); f[5] = bfhi(u.z); f[6] = bflo(u.w); f[7] = bfhi(u.w);
}

namespace pg8 {
constexpr int BM = 256, BK = 64, HALF = 128, HTB = HALF * BK * 2, STAGE_BYTES = 8 * HTB, NXCD = 8, WGM = 8;
__host__ __device__ __forceinline__ int lds_byte(int r, int c) { const int st = (r >> 4) * 2 + (c >> 5), rr = r & 15, cc = c & 31, ob = rr * 64 + cc * 2; return st * 1024 + (ob ^ (((ob >> 9) & 1) << 5)); }
__host__ __device__ __forceinline__ void stage_rc(int b, int& R, int& C) { const int st = b / 1024, sb = b % 1024, swz = sb ^ (((sb >> 9) & 1) << 5); R = (st >> 1) * 16 + swz / 64; C = (st & 1) * 32 + (swz % 64) / 2; }
__host__ __device__ __forceinline__ int perm32(int rho) { const int n = rho >> 4, i = rho & 15; return 8 * (i >> 2) + 4 * n + (i & 3); }
struct Unit { int pm, pn; };
struct Gemm { const bf16_t* A; const bf16_t* Bt; int M, N, K; };

__device__ __forceinline__ void tile_of(int wgid, int nM, int nN, Unit& u) {
    const int nwg = nM * nN;
    { const int q = nwg / NXCD, r = nwg % NXCD, xcd = wgid % NXCD, off = wgid / NXCD; wgid = (xcd < r ? xcd * (q + 1) : r * (q + 1) + (xcd - r) * q) + off; }
    const int nig = WGM * nN, gid = wgid / nig, fm = gid * WGM, gsz = (nM - fm) < WGM ? (nM - fm) : WGM;
    u.pm = fm + ((wgid % nig) % gsz); u.pn = (wgid % nig) / gsz;
}
struct StaticOrder {
    int nM, nN, nwg, G, c;
    __device__ void init(int M, int N, int G_, int c_) { nM = M / BM; nN = N / BM; nwg = nM * nN; G = G_; c = c_; }
    __device__ bool next(int i, Unit& u) const { const long L = (long)i * G + c; if (L >= nwg) return false; tile_of((int)L, nM, nN, u); return true; }
};
struct PairOrder {
    int nM, nN, nwg, G, c;
    __device__ void init(int M, int N, int G_, int c_) { nM = M / BM; nN = N / BM; nwg = nM * nN; G = G_; c = c_; }
    __device__ bool next(int i, Unit& u) const { const long L = (long)(i >> 1) * G + c; if (L >= nwg) return false; tile_of((int)L, nM, nN, u); if (i & 1) { u.pm += nM; u.pn += nN; } return true; }
};

template <class Epi, class Sched>
__device__ __forceinline__ void gemm_phase(LAS unsigned char* lds, const Gemm g, const Sched& S, const Epi& E) {
    const int tid = threadIdx.x, wid = __builtin_amdgcn_readfirstlane(tid >> 6), lane = tid & 63, wr = wid >> 2, wc = wid & 3, fr = lane & 15, fq = lane >> 4;
    const int K = g.K, nt = K / BK;
    unsigned voffA[2], voffB[2];
#pragma unroll
    for (int i = 0; i < 2; ++i) { int R, C; stage_rc(tid * 16 + i * 8192, R, C); const int Rb = Epi::PERM ? ((R & ~31) + perm32(R & 31)) : R;
        voffA[i] = (unsigned)(R * K + C) * 2u; voffB[i] = (unsigned)(Rb * K + C) * 2u; }
    const size_t kstep = (size_t)(BK * 2);
    const size_t hstep = (size_t)HALF * K * 2;
    const size_t tstep = 2 * hstep;
    const unsigned ldsw = (unsigned)wid * 1024u;
    const int aoff = lds_byte(wr * 64 + fr, fq * 8), boff = lds_byte(wc * 32 + fr, fq * 8);
#define PG8_SA(b, h) (((b) * 2 + (h)) * HTB)
#define PG8_SB(b, h) ((4 + (b) * 2 + (h)) * HTB)
#define PG8_STAGE(bufoff, gbase, voff) do { _Pragma("unroll") for (int _i = 0; _i < 2; ++_i) \
        __builtin_amdgcn_global_load_lds((const unsigned*)((const char*)(gbase) + (voff)[_i]), (LAS unsigned*)(lds + (bufoff) + ldsw + _i * 8192), 16, 0, 0); } while (0)
#define PG8_LDA(dst, b, h) do { _Pragma("unroll") for (int m = 0; m < 4; ++m) _Pragma("unroll") for (int k = 0; k < 2; ++k) dst[m][k] = *(const LAS bf16x8*)(lds + PG8_SA(b, h) + aoff + m * 2048 + k * 1024); } while (0)
#define PG8_LDB(dst, b, h) do { _Pragma("unroll") for (int n = 0; n < 2; ++n) _Pragma("unroll") for (int k = 0; k < 2; ++k) dst[n][k] = *(const LAS bf16x8*)(lds + PG8_SB(b, h) + boff + n * 2048 + k * 1024); } while (0)
#define PG8_MMA(ai, bj, At, Bt) do { __builtin_amdgcn_s_setprio(1); _Pragma("unroll") for (int m = 0; m < 4; ++m) _Pragma("unroll") for (int n = 0; n < 2; ++n) _Pragma("unroll") for (int k = 0; k < 2; ++k) \
        acc[ai][bj][m][n] = __builtin_amdgcn_mfma_f32_16x16x32_bf16(Bt[n][k], At[m][k], acc[ai][bj][m][n], 0, 0, 0); __builtin_amdgcn_s_setprio(0); } while (0)
#define PG8_WAIT_V(n) asm volatile("s_waitcnt vmcnt(" #n ")" ::: "memory")
#define PG8_WAIT_L(n) asm volatile("s_waitcnt lgkmcnt(" #n ")" ::: "memory")
#define PG8_BAR __builtin_amdgcn_s_barrier()
#define PG8_SCHED __builtin_amdgcn_sched_barrier(0)
    Unit cur, nxt; int ui = 0;
    if (!S.next(0, cur)) return;
    f32x4 acc[2][2][4][2];
#pragma unroll
    for (int a = 0; a < 2; ++a)
#pragma unroll
        for (int b = 0; b < 2; ++b)
#pragma unroll
            for (int m = 0; m < 4; ++m)
#pragma unroll
                for (int n = 0; n < 2; ++n) acc[a][b][m][n] = (f32x4){0.f, 0.f, 0.f, 0.f};
    bf16x8 At[4][2], B0[2][2], B1[2][2];
    const char* cA = (const char*)g.A + (size_t)cur.pm * tstep; const char* cB = (const char*)g.Bt + (size_t)cur.pn * tstep;
    PG8_STAGE(PG8_SB(0, 0), cB, voffB); PG8_STAGE(PG8_SA(0, 0), cA, voffA); PG8_STAGE(PG8_SB(0, 1), cB + hstep, voffB); PG8_STAGE(PG8_SA(0, 1), cA + hstep, voffA);
    if (wr == 1) PG8_BAR;
    PG8_WAIT_V(4); PG8_BAR;
    PG8_STAGE(PG8_SB(1, 0), cB + kstep, voffB); PG8_STAGE(PG8_SA(1, 0), cA + kstep, voffA); PG8_STAGE(PG8_SB(1, 1), cB + hstep + kstep, voffB);
    PG8_WAIT_V(6); PG8_BAR;
    for (;;) {
        const bool has_next = S.next(ui + 1, nxt);
        const char* nA = has_next ? (const char*)g.A + (size_t)nxt.pm * tstep : cA; const char* nB = has_next ? (const char*)g.Bt + (size_t)nxt.pn * tstep : cB;
        for (int t = 0; t < nt; t += 2) {
            const bool last = (t == nt - 2);
            const char* a1 = cA + (size_t)(t + 1) * kstep;
            const char* a2 = last ? nA : cA + (size_t)(t + 2) * kstep; const char* b2 = last ? nB : cB + (size_t)(t + 2) * kstep;
            const char* a3 = a2 + kstep; const char* b3 = b2 + kstep;
            PG8_LDB(B0, 0, 0); PG8_SCHED; PG8_LDA(At, 0, 0); PG8_STAGE(PG8_SA(1, 1), a1 + hstep, voffA);
            PG8_WAIT_L(8); PG8_BAR; PG8_WAIT_L(0); PG8_MMA(0, 0, At, B0); PG8_BAR; PG8_SCHED;
            PG8_LDB(B1, 0, 1); PG8_STAGE(PG8_SB(0, 0), b2, voffB);
            PG8_BAR; PG8_WAIT_L(0); PG8_MMA(0, 1, At, B1); PG8_BAR;
            PG8_LDA(At, 0, 1); PG8_STAGE(PG8_SA(0, 0), a2, voffA);
            PG8_BAR; PG8_WAIT_L(0); PG8_MMA(1, 0, At, B0); PG8_BAR; PG8_SCHED;
            PG8_STAGE(PG8_SB(0, 1), b2 + hstep, voffB);
            PG8_WAIT_V(6); PG8_BAR; PG8_MMA(1, 1, At, B1); PG8_BAR;
            PG8_LDB(B0, 1, 0); PG8_SCHED; PG8_LDA(At, 1, 0); PG8_STAGE(PG8_SA(0, 1), a2 + hstep, voffA);
            PG8_WAIT_L(8); PG8_BAR; PG8_WAIT_L(0); PG8_MMA(0, 0, At, B0); PG8_BAR; PG8_SCHED;
            PG8_LDB(B1, 1, 1); PG8_STAGE(PG8_SB(1, 0), b3, voffB);
            PG8_BAR; PG8_WAIT_L(0); PG8_MMA(0, 1, At, B1); PG8_BAR;
            PG8_LDA(At, 1, 1); PG8_STAGE(PG8_SA(1, 0), a3, voffA);
            PG8_BAR; PG8_WAIT_L(0); PG8_MMA(1, 0, At, B0); PG8_BAR; PG8_SCHED;
            PG8_STAGE(PG8_SB(1, 1), b3 + hstep, voffB);
            PG8_WAIT_V(6); PG8_BAR; PG8_MMA(1, 1, At, B1); PG8_BAR;
        }
        const bool keep = E(acc, cur, wr, wc, fr, fq);
        if (!has_next) break;
        if (!keep) {
#pragma unroll
            for (int a = 0; a < 2; ++a)
#pragma unroll
                for (int b = 0; b < 2; ++b)
#pragma unroll
                    for (int m = 0; m < 4; ++m)
#pragma unroll
                        for (int n = 0; n < 2; ++n) acc[a][b][m][n] = (f32x4){0.f, 0.f, 0.f, 0.f};
        }
        cur = nxt; cA = nA; cB = nB; ++ui;
    }
    PG8_WAIT_V(0);
    if (wr == 0) PG8_BAR;
    PG8_BAR;
#undef PG8_SA
#undef PG8_SB
#undef PG8_STAGE
#undef PG8_LDA
#undef PG8_LDB
#undef PG8_MMA
#undef PG8_WAIT_V
#undef PG8_WAIT_L
#undef PG8_BAR
#undef PG8_SCHED
}

struct EpiZ {
    static constexpr bool PERM = true;
    unsigned char* ws;
    __device__ __forceinline__ bool operator()(f32x4 (&acc)[2][2][4][2], const Unit& u, int wr, int wc, int fr, int fq) const {
        bf16_t* base; int ld, colt;
        if (u.pn < 24) { base = (bf16_t*)(ws + OFF_ZR) + (size_t)(u.pn >> 3) * GS; ld = D; colt = (u.pn & 7) * 256; }
        else if (u.pn < 26) { base = (bf16_t*)(ws + OFF_ZWD); ld = 512; colt = (u.pn - 24) * 256; }
        else { const int q = u.pn - 26; base = (bf16_t*)(ws + OFF_ZG) + (size_t)(q >> 3) * GS; ld = D; colt = (q & 7) * 256; }
        const int row0 = u.pm * BM + wr * 64 + fr, col0 = colt + wc * 32 + 8 * fq;
#pragma unroll
        for (int ai = 0; ai < 2; ++ai)
#pragma unroll
            for (int m = 0; m < 4; ++m) { bf16_t* rowp = base + (size_t)(row0 + ai * HALF + m * 16) * ld + col0;
#pragma unroll
                for (int bj = 0; bj < 2; ++bj) { const f32x4 v0 = acc[ai][bj][m][0], v1 = acc[ai][bj][m][1];
                    u32x4 w; w.x = pk2(v0[0], v0[1]); w.y = pk2(v0[2], v0[3]); w.z = pk2(v1[0], v1[1]); w.w = pk2(v1[2], v1[3]);
                    *(u32x4*)(rowp + bj * HALF) = w; } }
        return false;
    }
};
struct EpiMerge {
    static constexpr bool PERM = true;
    const bf16_t *ma, *mb; bf16_t* out;
    __device__ __forceinline__ bool operator()(f32x4 (&acc)[2][2][4][2], const Unit& u, int wr, int wc, int fr, int fq) const {
        const bool isb = u.pm >= 32; const int pm = isb ? u.pm - 32 : u.pm, pn = isb ? u.pn - 8 : u.pn;
        const int row0 = pm * BM + wr * 64 + fr, col0 = pn * BM + wc * 32 + 8 * fq;
#pragma unroll
        for (int ai = 0; ai < 2; ++ai)
#pragma unroll
            for (int m = 0; m < 4; ++m) { const size_t ro = (size_t)(row0 + ai * HALF + m * 16) * D + col0;
#pragma unroll
                for (int bj = 0; bj < 2; ++bj) {
                    float fb[8]; unpack8(*(const u32x4*)(mb + ro + bj * HALF), fb);
                    if (!isb) {
                        float fa[8]; unpack8(*(const u32x4*)(ma + ro + bj * HALF), fa);
#pragma unroll
                        for (int j = 0; j < 4; ++j) { acc[ai][bj][m][0][j] *= (1.f + __expf(-fb[j])) / (1.f + __expf(-fa[j])); acc[ai][bj][m][1][j] *= (1.f + __expf(-fb[4 + j])) / (1.f + __expf(-fa[4 + j])); }
                    } else {
                        f32x4 v0 = acc[ai][bj][m][0], v1 = acc[ai][bj][m][1];
#pragma unroll
                        for (int j = 0; j < 4; ++j) { v0[j] *= sigm(fb[j]); v1[j] *= sigm(fb[4 + j]); }
                        u32x4 w; w.x = pk2(v0[0], v0[1]); w.y = pk2(v0[2], v0[3]); w.z = pk2(v1[0], v1[1]); w.w = pk2(v1[2], v1[3]);
                        *(u32x4*)(out + ro + bj * HALF) = w;
                    } } }
        return !isb;
    }
};
struct EpiOut {
    static constexpr bool PERM = false;
    const float *xp, *xs, *modg; float* out;
    __device__ __forceinline__ bool operator()(f32x4 (&acc)[2][2][4][2], const Unit& u, int wr, int wc, int fr, int fq) const {
        const int row0 = u.pm * BM + wr * 64 + fr, col0 = u.pn * BM + wc * 32 + 4 * fq;
        const int mi = (u.pm < 16) ? 0 : 1 + ((u.pm - 16) >> 2);
        f32x4 gv[2][2];
#pragma unroll
        for (int bj = 0; bj < 2; ++bj)
#pragma unroll
            for (int n = 0; n < 2; ++n) gv[bj][n] = *(const f32x4*)(modg + mi * 2048 + col0 + bj * HALF + n * 16);
#pragma unroll
        for (int ai = 0; ai < 2; ++ai)
#pragma unroll
            for (int m = 0; m < 4; ++m) { const int row = row0 + ai * HALF + m * 16;
                const float* xr = (row < NCTX ? xp + (size_t)row * D : xs + (size_t)(row - NCTX) * D) + col0; float* orow = out + (size_t)row * D + col0;
#pragma unroll
                for (int bj = 0; bj < 2; ++bj)
#pragma unroll
                    for (int n = 0; n < 2; ++n) { const f32x4 xv = *(const f32x4*)(xr + bj * HALF + n * 16); *(f32x4*)(orow + bj * HALF + n * 16) = xv + gv[bj][n] * acc[ai][bj][m][n]; } }
        return false;
    }
};
}

__device__ __forceinline__ void transpose_item(const float* W, int N, bf16_t* WT, int K, int item, int nblk, float* scr, int lane, int pad_from, int pad_amt) {
    const int kb = item / nblk, nb = item % nblk, k0 = 64 * kb, n0 = 32 * nb;
#pragma unroll 8
    for (int i = 0; i < 32; ++i) { const int kk = 2 * i + (lane >> 5); scr[kk * 33 + (lane & 31)] = W[(size_t)(k0 + kk) * N + n0 + (lane & 31)]; }
    asm volatile("s_waitcnt lgkmcnt(0)" ::: "memory");
    const int c = lane & 7; const int roff = (n0 >= pad_from) ? pad_amt : 0;
#pragma unroll
    for (int j = 0; j < 4; ++j) { const int n = (lane >> 3) + 8 * j; const float* s = scr + (8 * c) * 33 + n;
        u32x4 o; o.x = pk2(s[0 * 33], s[1 * 33]); o.y = pk2(s[2 * 33], s[3 * 33]); o.z = pk2(s[4 * 33], s[5 * 33]); o.w = pk2(s[6 * 33], s[7 * 33]);
        *(u32x4*)(WT + (size_t)(roff + n0 + n) * K + k0 + 8 * c) = o; }
    asm volatile("s_waitcnt lgkmcnt(0)" ::: "memory");
}
__device__ __forceinline__ void p0_prep(const Params& p, float* ldsf) {
    const int tid = threadIdx.x, lane = tid & 63, wave = tid >> 6, G = gridDim.x;
    float* modp = (float*)(p.ws + OFF_MODP);
    for (int u = blockIdx.x; u < 48; u += G) {
        const int cg3 = u % 3, ks = u / 3, k0 = ks * 128;
        __syncthreads();
        for (int i = tid; i < 5 * 128; i += 512) { const int mi = i >> 7, k = i & 127; const float* cv = mi == 0 ? p.c_ctx : p.c + (mi - 1) * 2048; const float x = cv[k0 + k]; ldsf[i] = x / (1.f + __expf(-x)); }
        __syncthreads();
        const int c0 = cg3 * 2048 + 4 * tid;
        f32x4 a0 = {0.f, 0.f, 0.f, 0.f}, a1 = a0, a2 = a0, a3 = a0, a4 = a0;
#pragma unroll 8
        for (int k = 0; k < 128; ++k) { const f32x4 w = *(const f32x4*)(p.ada_w + (size_t)(k0 + k) * 6144 + c0);
            a0 += ldsf[k] * w; a1 += ldsf[128 + k] * w; a2 += ldsf[256 + k] * w; a3 += ldsf[384 + k] * w; a4 += ldsf[512 + k] * w; }
        float* o = modp + (size_t)(ks * 5) * 6144 + c0;
        *(f32x4*)(o) = a0; *(f32x4*)(o + 6144) = a1; *(f32x4*)(o + 2 * 6144) = a2; *(f32x4*)(o + 3 * 6144) = a3; *(f32x4*)(o + 4 * 6144) = a4;
    }
    __syncthreads();
    float* scr = ldsf + wave * (64 * 33);
    bf16_t* WinT = (bf16_t*)(p.ws + OFF_WINT); bf16_t* WabT = (bf16_t*)(p.ws + OFF_WABT); bf16_t* WoT = (bf16_t*)(p.ws + OFF_WOT); bf16_t* LT = (bf16_t*)(p.ws + OFF_LT);
    constexpr int I_IN = 32 * (DIN / 32), I_SQ = 32 * 64, NITEMS = I_IN + 3 * I_SQ + 128 + 128;
    for (int it = blockIdx.x * 8 + wave; it < NITEMS; it += G * 8) {
        int r = it;
        if (r < I_IN) { transpose_item(p.w_in, DIN, WinT, D, r, DIN / 32, scr, lane, NSH, 128); continue; } r -= I_IN;
        if (r < I_SQ) { transpose_item(p.w_out_a, D, WabT, D, r, 64, scr, lane, 1 << 30, 0); continue; } r -= I_SQ;
        if (r < I_SQ) { transpose_item(p.w_out_b, D, WabT + (size_t)D * D, D, r, 64, scr, lane, 1 << 30, 0); continue; } r -= I_SQ;
        if (r < I_SQ) { transpose_item(p.w_o, D, WoT, D, r, 64, scr, lane, 1 << 30, 0); continue; } r -= I_SQ;
        if (r < 128) {
            u32x4 z = {0u, 0u, 0u, 0u}; bf16_t* row = WinT + (size_t)(NSH + r) * D;
#pragma unroll
            for (int j = 0; j < 4; ++j) *(u32x4*)(row + (lane + 64 * j) * 8) = z;
            continue; }
        r -= 128;
        { const int m = r >> 5, n = (r & 31) * 64 + lane; const float* src = ((m >> 1) ? p.a2 : p.w2) + (size_t)(m & 1) * 96 * 2048 + n;
            bf16_t* dst = LT + ((size_t)m * 2048 + n) * 96;
#pragma unroll 4
            for (int kc = 0; kc < 12; ++kc) { const float* s = src + (size_t)(8 * kc) * 2048;
                u32x4 o; o.x = pk2(s[0], s[2048]); o.y = pk2(s[2 * 2048], s[3 * 2048]); o.z = pk2(s[4 * 2048], s[5 * 2048]); o.w = pk2(s[6 * 2048], s[7 * 2048]);
                *(u32x4*)(dst + 8 * kc) = o; } }
    }
}

__device__ __forceinline__ void p1_norm(const Params& p, float* ldsf) {
    const int tid = threadIdx.x, lane = tid & 63, wave = tid >> 6, G = gridDim.x;
    const float* modp = (const float*)(p.ws + OFF_MODP); float* modg = (float*)(p.ws + OFF_MODG); bf16_t* H = (bf16_t*)(p.ws + OFF_H);
    for (int mi = blockIdx.x; mi < 5; mi += G) {
        const int c4 = 4 * tid; f32x4 g = *(const f32x4*)(p.ada_b + 4096 + c4);
        for (int ks = 0; ks < 16; ++ks) g += *(const f32x4*)(modp + (size_t)(ks * 5 + mi) * 6144 + 4096 + c4);
        *(f32x4*)(modg + mi * 2048 + c4) = g;
    }
    for (int ch = blockIdx.x; ch < 256; ch += G) {
        const int t0 = ch * 32, mi = t0 < NCTX ? 0 : 1 + ((t0 - NCTX) >> 10);
        __syncthreads();
        { const int c4 = 4 * tid; f32x4 sh = *(const f32x4*)(p.ada_b + c4), sc = *(const f32x4*)(p.ada_b + 2048 + c4);
            for (int ks = 0; ks < 16; ++ks) { const float* m = modp + (size_t)(ks * 5 + mi) * 6144 + c4; sh += *(const f32x4*)m; sc += *(const f32x4*)(m + 2048); }
            *(f32x4*)(ldsf + c4) = sh; *(f32x4*)(ldsf + 2048 + c4) = sc + 1.f; }
        __syncthreads();
        for (int i = 0; i < 4; ++i) {
            const int t = t0 + wave * 4 + i; const float* xr = t < NCTX ? p.xp + (size_t)t * D : p.xs + (size_t)(t - NCTX) * D;
            f32x4 v[8]; float ss = 0.f;
#pragma unroll
            for (int j = 0; j < 8; ++j) { v[j] = *(const f32x4*)(xr + 4 * lane + 256 * j); ss += (v[j].x * v[j].x + v[j].y * v[j].y) + (v[j].z * v[j].z + v[j].w * v[j].w); }
            const float rstd = rsqrtf(wave_sum(ss) * (1.f / D) + 1e-6f);
#pragma unroll
            for (int j = 0; j < 8; ++j) { const int c = 4 * lane + 256 * j; const f32x4 g = *(const f32x4*)(p.norm_g + c), sh = *(const f32x4*)(ldsf + c), sc = *(const f32x4*)(ldsf + 2048 + c);
                const f32x4 hv = (v[j] * rstd * g) * sc + sh; u32x2 o; o.x = pk2(hv.x, hv.y); o.y = pk2(hv.z, hv.w);
                *(u32x2*)(H + (size_t)t * D + c) = o; }
        }
    }
}

__device__ __forceinline__ void p3_lora_conv(const Params& p) {
    const int tid = threadIdx.x, lane = tid & 63, wave = tid >> 6, G = gridDim.x, fr = lane & 15, fq = lane >> 4;
    const bf16_t* zwd = (const bf16_t*)(p.ws + OFF_ZWD); const bf16_t* LT = (const bf16_t*)(p.ws + OFF_LT);
    __half* LAM = (__half*)(p.ws + OFF_LAM);
    for (int u = blockIdx.x * 8 + wave; u < 2048; u += G * 8) {
        const int mt = u >> 2, nq = u & 3, t = mt * 16 + fr;
        const int L = t < NCTX ? 256 : 1024, tau = t & (L - 1);
        const bool hp = tau != 0, hn = tau != L - 1;
        bf16x8 af[4][3];
#pragma unroll
        for (int m = 0; m < 4; ++m)
#pragma unroll
            for (int ks = 0; ks < 3; ++ks) {
                const int c = m * 96 + 32 * ks + 8 * fq;
                const u32x4 zc = *(const u32x4*)(zwd + (size_t)t * 512 + c);
                u32x4 zp = {0u, 0u, 0u, 0u}, zn = {0u, 0u, 0u, 0u};
                if (hp) zp = *(const u32x4*)(zwd + (size_t)(t - 1) * 512 + c);
                if (hn) zn = *(const u32x4*)(zwd + (size_t)(t + 1) * 512 + c);
                float fc[8], fp[8], fn[8]; unpack8(zc, fc); unpack8(zp, fp); unpack8(zn, fn);
                const f32x4 mp0 = *(const f32x4*)(p.mu_prev + 6144 + c), mp1 = *(const f32x4*)(p.mu_prev + 6144 + c + 4), mn0 = *(const f32x4*)(p.mu_next + 6144 + c), mn1 = *(const f32x4*)(p.mu_next + 6144 + c + 4);
                float o[8];
#pragma unroll
                for (int j = 0; j < 8; ++j) { const float mp = j < 4 ? mp0[j & 3] : mp1[j & 3], mn = j < 4 ? mn0[j & 3] : mn1[j & 3];
                    float zsv = fc[j] + mp * (fp[j] - fc[j]) + mn * (fn[j] - fc[j]);
                    if (m < 2) zsv = 1.f - 2.f / (1.f + __expf(2.f * zsv));
                    o[j] = zsv; }
                u32x4 pk; pk.x = pk2(o[0], o[1]); pk.y = pk2(o[2], o[3]); pk.z = pk2(o[4], o[5]); pk.w = pk2(o[6], o[7]);
                af[m][ks] = __builtin_bit_cast(bf16x8, pk);
            }
        for (int ng = 0; ng < 8; ++ng) {
            const int n0 = nq * 512 + ng * 64;
#pragma unroll
            for (int m = 0; m < 4; ++m) {
                f32x4 acc[4];
#pragma unroll
                for (int nt = 0; nt < 4; ++nt) { acc[nt] = (f32x4){0.f, 0.f, 0.f, 0.f};
#pragma unroll
                    for (int ks = 0; ks < 3; ++ks) { const bf16x8 bw = *(const bf16x8*)(LT + ((size_t)m * 2048 + n0 + nt * 16 + fr) * 96 + 32 * ks + 8 * fq);
                        acc[nt] = __builtin_amdgcn_mfma_f32_16x16x32_bf16(bw, af[m][ks], acc[nt], 0, 0, 0); } }
                const int dir = m & 1, kind = m >> 1; const float* bias = (kind ? p.a0 : p.w0) + dir * 2048;
#pragma unroll
                for (int nt = 0; nt < 4; ++nt) { const int ch = n0 + nt * 16 + 4 * fq; const f32x4 bv = *(const f32x4*)(bias + ch);
                    float r[4];
#pragma unroll
                    for (int j = 0; j < 4; ++j) { const float s = sigm(bv[j] + acc[nt][j]); r[j] = kind ? s : 0.60653066f * s; }
                    const __half2 h0 = __floats2half2_rn(r[0], r[1]), h1 = __floats2half2_rn(r[2], r[3]);
                    u32x2 o; o.x = __builtin_bit_cast(unsigned, h0); o.y = __builtin_bit_cast(unsigned, h1);
                    *(u32x2*)(LAM + (size_t)(kind * 2 + dir) * GS + (size_t)t * D + ch) = o; }
            }
        }
    }
    const bf16_t* zbg = (const bf16_t*)(p.ws + OFF_ZG) + 1 * GS; const bf16_t* zcg = zbg + GS; const bf16_t* zxb = zcg + GS; const bf16_t* zgb = zxb + GS;
    bf16_t* yb = (bf16_t*)(p.ws + OFF_WINT) + GS;
    for (int i = blockIdx.x * 512 + tid; i < NTOK * 256; i += G * 512) {
        const int t = i >> 8, c = (i & 255) * 8;
        const int Lr = t < NCTX ? 256 : 64, pos = t & (Lr - 1);
        const size_t o = (size_t)t * D + c;
        float cgc[8], xbc[8], pc[8], pp[8], pn[8];
        unpack8(*(const u32x4*)(zcg + o), cgc); unpack8(*(const u32x4*)(zxb + o), xbc);
#pragma unroll
        for (int j = 0; j < 8; ++j) { pc[j] = cgc[j] * xbc[j]; pp[j] = 0.f; pn[j] = 0.f; }
        if (pos != 0) { unpack8(*(const u32x4*)(zcg + o - D), cgc); unpack8(*(const u32x4*)(zxb + o - D), xbc);
#pragma unroll
            for (int j = 0; j < 8; ++j) pp[j] = cgc[j] * xbc[j]; }
        if (pos != Lr - 1) { unpack8(*(const u32x4*)(zcg + o + D), cgc); unpack8(*(const u32x4*)(zxb + o + D), xbc);
#pragma unroll
            for (int j = 0; j < 8; ++j) pn[j] = cgc[j] * xbc[j]; }
        float bg[8], gb[8]; unpack8(*(const u32x4*)(zbg + o), bg); unpack8(*(const u32x4*)(zgb + o), gb);
        float r[8];
#pragma unroll
        for (int j = 0; j < 8; ++j) { const float w0 = p.conv_w[c + j], w1 = p.conv_w[2048 + c + j], w2 = p.conv_w[4096 + c + j];
            const float uu = w0 * pp[j] + w1 * pc[j] + w2 * pn[j]; r[j] = bg[j] * uu * (gb[j] / (1.f + __expf(-gb[j]))); }
        u32x4 w; w.x = pk2(r[0], r[1]); w.y = pk2(r[2], r[3]); w.z = pk2(r[4], r[5]); w.w = pk2(r[6], r[7]);
        *(u32x4*)(yb + o) = w;
    }
}

template <int NP>
__device__ __forceinline__ void scan_prep(const Params& p, float* buf, int seqbase, int L, int lo, int i0, int h, int dir, int lane,
                                          float mpr, float mnr, float mpk, float mnk, float mpv, float mnv, float kkc, float kac, float rkc) {
    const bf16_t* zr = (const bf16_t*)(p.ws + OFF_ZR); const bf16_t* zk = zr + GS; const bf16_t* zv = zk + GS;
    const __half* LAMd = (const __half*)(p.ws + OFF_LAM) + (size_t)dir * GS; const __half* AVd = LAMd + 2 * GS;
    float* bs = (float*)(p.ws + OFF_BS) + (size_t)dir * NTOK * 32;
    const int c = h * 64 + lane;
    float rr[NP + 2], rk[NP + 2], rv[NP + 2], lam[NP], av[NP];
#pragma unroll
    for (int x = 0; x < NP + 2; ++x) {
        const int tau = lo + i0 - 1 + x; const bool ok = (tau >= 0) && (tau < L);
        const size_t off = (size_t)(seqbase + (ok ? tau : lo)) * D + c;
        const float a = bf1(zr[off]), b = bf1(zk[off]), cc = bf1(zv[off]);
        rr[x] = ok ? a : 0.f; rk[x] = ok ? b : 0.f; rv[x] = ok ? cc : 0.f;
    }
#pragma unroll
    for (int i = 0; i < NP; ++i) { const size_t off = (size_t)(seqbase + lo + i0 + i) * D + c; lam[i] = __half2float(LAMd[off]); av[i] = __half2float(AVd[off]); }
#pragma unroll
    for (int i = 0; i < NP; ++i) {
        const float rs = rr[i + 1] + mpr * (rr[i] - rr[i + 1]) + mnr * (rr[i + 2] - rr[i + 1]);
        const float ks = rk[i + 1] + mpk * (rk[i] - rk[i + 1]) + mnk * (rk[i + 2] - rk[i + 1]);
        const float vs = rv[i + 1] + mpv * (rv[i] - rv[i + 1]) + mnv * (rv[i + 2] - rv[i + 1]);
        const float kkr = ks * kkc; const float ss = wave_sum(kkr * kkr); const float kk = kkr / fmaxf(sqrtf(ss), 1e-12f);
        const float a = av[i], w = __expf(-lam[i]), kd = ks * (1.f + (a - 1.f) * kac), b = kk * a;
        const float bon = wave_sum(rs * kd * rkc);
        if (lane == 0) bs[(size_t)(seqbase + lo + i0 + i) * 32 + h] = bon;
        const int slot = dir ? 7 - (i0 + i) : (i0 + i);
        float* o = buf + slot * 384;
        o[lane] = w; o[64 + lane] = b; o[128 + lane] = kd; o[192 + lane] = rs; o[256 + lane] = -kk; o[320 + lane] = vs;
    }
}
template <int R>
__device__ __forceinline__ void scan_steps(const float* buf, float (&S)[R][16], float* yd, int seqbase, int lo, int dir, int h, int lane, int rowbase) {
    const int q = lane & 3, il = lane >> 2;
#pragma unroll 1
    for (int s = 0; s < 8; ++s) {
        const float* o = buf + s * 384 + 16 * q;
        float w[16], b[16], k[16], r[16], a[16];
#pragma unroll
        for (int x = 0; x < 4; ++x) { const f32x4 w4 = *(const f32x4*)(o + 4 * x), b4 = *(const f32x4*)(o + 64 + 4 * x), k4 = *(const f32x4*)(o + 128 + 4 * x), r4 = *(const f32x4*)(o + 192 + 4 * x), a4 = *(const f32x4*)(o + 256 + 4 * x);
#pragma unroll
            for (int j = 0; j < 4; ++j) { w[4 * x + j] = w4[j]; b[4 * x + j] = b4[j]; k[4 * x + j] = k4[j]; r[4 * x + j] = r4[j]; a[4 * x + j] = a4[j]; } }
        float v[R];
        if (R == 4) { const f32x4 v4 = *(const f32x4*)(buf + s * 384 + 320 + 4 * il); v[0] = v4[0]; v[R > 1 ? 1 : 0] = v4[1]; v[R > 2 ? 2 : 0] = v4[2]; v[R > 3 ? 3 : 0] = v4[3]; }
        else v[0] = buf[s * 384 + 320 + rowbase + il];
        float yv[R];
#pragma unroll
        for (int rr = 0; rr < R; ++rr) {
            float sa0 = 0.f, sa1 = 0.f;
#pragma unroll
            for (int j = 0; j < 16; j += 2) { sa0 += S[rr][j] * a[j]; sa1 += S[rr][j + 1] * a[j + 1]; }
            const float sa = quad_sum(sa0 + sa1);
            float y0 = 0.f, y1 = 0.f;
#pragma unroll
            for (int j = 0; j < 16; j += 2) {
                S[rr][j] = S[rr][j] * w[j] + (sa * b[j] + v[rr] * k[j]); y0 += S[rr][j] * r[j];
                S[rr][j + 1] = S[rr][j + 1] * w[j + 1] + (sa * b[j + 1] + v[rr] * k[j + 1]); y1 += S[rr][j + 1] * r[j + 1]; }
            yv[rr] = quad_sum(y0 + y1);
        }
        const int tau = dir ? lo + 7 - s : lo + s;
        float* yp = yd + (size_t)(seqbase + tau) * D + h * 64;
        if (R == 4) { const float y = q == 0 ? yv[0] : (q == 1 ? yv[R > 1 ? 1 : 0] : (q == 2 ? yv[R > 2 ? 2 : 0] : yv[R > 3 ? 3 : 0])); yp[lane] = y; }
        else if (q == 0) yp[rowbase + il] = yv[0];
    }
}
__device__ __forceinline__ void p4_scan(const Params& p, float* ldsf) {
    const int tid = threadIdx.x, lane = tid & 63, wave = tid >> 6, G = gridDim.x, q = lane & 3, il = lane >> 2;
    float* ydir = (float*)(p.ws + OFF_YDIR);
    for (int bu = blockIdx.x; bu < 256; bu += G) {
        const int type = bu & 1, idx = bu >> 1;
        __syncthreads();
        if (type == 0 && EXP_LAT) {
            const int hd = idx * 2 + (wave >> 2), b = hd >> 6, h = (hd >> 1) & 31, dir = hd & 1, wsub = wave & 3;
            const int seqbase = NCTX + b * 1024, L = 1024, c = h * 64 + lane;
            const float mpr = p.mu_prev[c], mnr = p.mu_next[c], mpk = p.mu_prev[2048 + c], mnk = p.mu_next[2048 + c], mpv = p.mu_prev[4096 + c], mnv = p.mu_next[4096 + c];
            const float kkc = p.k_k[c], kac = p.k_a[c], rkc = p.r_k[c];
            float* base = ldsf + (wave >> 2) * (2 * 3072);
            float S[1][16];
            { const float* s0 = (dir ? p.st_b : p.st_f) + ((size_t)(b * 32 + h) * 64 + 16 * wsub + il) * 64 + 16 * q;
#pragma unroll
                for (int x = 0; x < 4; ++x) { const f32x4 v = *(const f32x4*)(s0 + 4 * x); S[0][4 * x] = v[0]; S[0][4 * x + 1] = v[1]; S[0][4 * x + 2] = v[2]; S[0][4 * x + 3] = v[3]; } }
            float* yd = ydir + (size_t)dir * GS;
            scan_prep<2>(p, base, seqbase, L, dir ? L - 8 : 0, 2 * wsub, h, dir, lane, mpr, mnr, mpk, mnk, mpv, mnv, kkc, kac, rkc);
            __syncthreads();
#pragma unroll 1
            for (int ck = 0; ck < 128; ++ck) {
                const int lo = dir ? L - 8 - 8 * ck : 8 * ck;
                if (ck + 1 < 128) scan_prep<2>(p, base + ((ck + 1) & 1) * 3072, seqbase, L, dir ? lo - 8 : lo + 8, 2 * wsub, h, dir, lane, mpr, mnr, mpk, mnk, mpv, mnv, kkc, kac, rkc);
                scan_steps<1>(base + (ck & 1) * 3072, S, yd, seqbase, lo, dir, h, lane, 16 * wsub);
                __syncthreads();
            }
        } else if (EXP_CTX) {
            const int u = idx * 8 + wave, sq = u >> 6, h = (u >> 1) & 31, dir = u & 1;
            const int seqbase = sq * 256, L = 256, c = h * 64 + lane;
            const float mpr = p.mu_prev[c], mnr = p.mu_next[c], mpk = p.mu_prev[2048 + c], mnk = p.mu_next[2048 + c], mpv = p.mu_prev[4096 + c], mnv = p.mu_next[4096 + c];
            const float kkc = p.k_k[c], kac = p.k_a[c], rkc = p.r_k[c];
            float* buf = ldsf + wave * 3072;
            float S[4][16];
#pragma unroll
            for (int rr = 0; rr < 4; ++rr)
#pragma unroll
                for (int j = 0; j < 16; ++j) S[rr][j] = 0.f;
            float* yd = ydir + (size_t)dir * GS;
#pragma unroll 1
            for (int ck = 0; ck < 32; ++ck) {
                const int lo = dir ? L - 8 - 8 * ck : 8 * ck;
                scan_prep<8>(p, buf, seqbase, L, lo, 0, h, dir, lane, mpr, mnr, mpk, mnk, mpv, mnv, kkc, kac, rkc);
                asm volatile("s_waitcnt lgkmcnt(0)" ::: "memory");
                scan_steps<4>(buf, S, yd, seqbase, lo, dir, h, lane, 0);
                asm volatile("s_waitcnt lgkmcnt(0)" ::: "memory");
            }
            if (EXP_ST) { float* so = p.out + GS + (size_t)dir * (16 * 32 * 4096) + ((size_t)(sq * 32 + h) * 64) * 64;
#pragma unroll
            for (int rr = 0; rr < 4; ++rr)
#pragma unroll
                for (int x = 0; x < 4; ++x) { f32x4 v = {S[rr][4 * x], S[rr][4 * x + 1], S[rr][4 * x + 2], S[rr][4 * x + 3]}; *(f32x4*)(so + (size_t)(4 * il + rr) * 64 + 16 * q + 4 * x) = v; } }
        }
    }
}

__device__ __forceinline__ void p5_gn(const Params& p) {
    const int tid = threadIdx.x, G = gridDim.x;
    const float* y0p = (const float*)(p.ws + OFF_YDIR); const float* y1p = y0p + GS;
    const float* bs0 = (const float*)(p.ws + OFF_BS); const float* bs1 = bs0 + (size_t)NTOK * 32;
    const bf16_t* zv = (const bf16_t*)(p.ws + OFF_ZR) + 2 * GS; const bf16_t* zga = (const bf16_t*)(p.ws + OFF_ZG);
    bf16_t* ya = (bf16_t*)(p.ws + OFF_WINT);
    for (int i = blockIdx.x * 512 + tid; i < NTOK * 512; i += G * 512) {
        const int t = i >> 9, c = (i & 511) * 4, h = c >> 6;
        const size_t o = (size_t)t * D + c;
        const f32x4 y = *(const f32x4*)(y0p + o) + *(const f32x4*)(y1p + o);
        float s = (y.x + y.y) + (y.z + y.w);
        s += __shfl_xor(s, 1); s += __shfl_xor(s, 2); s += __shfl_xor(s, 4); s += __shfl_xor(s, 8);
        const float mu = s * (1.f / 64.f); const f32x4 d = y - mu;
        float s2 = (d.x * d.x + d.y * d.y) + (d.z * d.z + d.w * d.w);
        s2 += __shfl_xor(s2, 1); s2 += __shfl_xor(s2, 2); s2 += __shfl_xor(s2, 4); s2 += __shfl_xor(s2, 8);
        const float rstd = rsqrtf(s2 * (1.f / 64.f) + 64e-5f);
        const int L = t < NCTX ? 256 : 1024, tau = t & (L - 1);
        const u32x2 vc = *(const u32x2*)(zv + o); u32x2 vp = {0u, 0u}, vn = {0u, 0u};
        if (tau != 0) vp = *(const u32x2*)(zv + o - D);
        if (tau != L - 1) vn = *(const u32x2*)(zv + o + D);
        const f32x4 fc = {bflo(vc.x), bfhi(vc.x), bflo(vc.y), bfhi(vc.y)}, fp = {bflo(vp.x), bfhi(vp.x), bflo(vp.y), bfhi(vp.y)}, fn = {bflo(vn.x), bfhi(vn.x), bflo(vn.y), bfhi(vn.y)};
        const f32x4 mp = *(const f32x4*)(p.mu_prev + 4096 + c), mn = *(const f32x4*)(p.mu_next + 4096 + c);
        const f32x4 vs = fc + mp * (fp - fc) + mn * (fn - fc);
        const float bon = bs0[(size_t)t * 32 + h] + bs1[(size_t)t * 32 + h];
        const f32x4 lg = *(const f32x4*)(p.lnx_g + c), lb = *(const f32x4*)(p.lnx_b + c);
        const u32x2 gu = *(const u32x2*)(zga + o); const f32x4 ga = {bflo(gu.x), bfhi(gu.x), bflo(gu.y), bfhi(gu.y)};
        f32x4 r = (d * rstd) * lg + lb + bon * vs;
#pragma unroll
        for (int j = 0; j < 4; ++j) r[j] *= ga[j] / (1.f + __expf(-ga[j]));
        u32x2 w; w.x = pk2(r[0], r[1]); w.y = pk2(r[2], r[3]);
        *(u32x2*)(ya + o) = w;
    }
}

__device__ __forceinline__ void p8_final(const Params& p) {
    const int tid = threadIdx.x, lane = tid & 63, wave = tid >> 6, G = gridDim.x;
    for (int t = blockIdx.x * 8 + wave; t < NTOK; t += G * 8) {
        float* xr = p.out + (size_t)t * D;
        f32x4 v[8]; float ss = 0.f;
#pragma unroll
        for (int j = 0; j < 8; ++j) { v[j] = *(const f32x4*)(xr + 4 * lane + 256 * j); ss += (v[j].x * v[j].x + v[j].y * v[j].y) + (v[j].z * v[j].z + v[j].w * v[j].w); }
        const float rstd = rsqrtf(wave_sum(ss) * (1.f / D) + 1e-6f);
#pragma unroll
        for (int j = 0; j < 8; ++j) { const int c = 4 * lane + 256 * j; const f32x4 g = *(const f32x4*)(p.final_g + c); *(f32x4*)(xr + c) = (v[j] * rstd) * g; }
    }
}

__global__ void __launch_bounds__(512, 2) mega(Params p) {
    extern __shared__ __attribute__((aligned(16))) unsigned char shm[];
    float* ldsf = (float*)shm;
    cg::grid_group grid = cg::this_grid();
    const int lo = p.ph_lo, hi = p.ph_hi;
    Params* slot = (Params*)(p.ws + OFF_PSLOT + (size_t)blockIdx.x * 256);
    if (lo == 0) { if (threadIdx.x == 0) *slot = p; p0_prep(p, ldsf); }
#define PHASE_BEGIN(k) if (lo <= (k) && (k) < hi) { if ((k) > lo) grid.sync(); const Params q = *slot;
#define PHASE_END }
    PHASE_BEGIN(1) p1_norm(q, ldsf); PHASE_END
    PHASE_BEGIN(2) pg8::Gemm g{(const bf16_t*)(q.ws + OFF_H), (const bf16_t*)(q.ws + OFF_WINT), NTOK, NPAD, D}; pg8::StaticOrder S; S.init(NTOK, NPAD, gridDim.x, blockIdx.x); pg8::EpiZ E{q.ws};
        pg8::gemm_phase((LAS unsigned char*)shm, g, S, E); PHASE_END
    PHASE_BEGIN(3) p3_lora_conv(q); PHASE_END
    PHASE_BEGIN(4) p4_scan(q, ldsf); PHASE_END
    PHASE_BEGIN(5) p5_gn(q); PHASE_END
    PHASE_BEGIN(6) pg8::Gemm g{(const bf16_t*)(q.ws + OFF_WINT), (const bf16_t*)(q.ws + OFF_WABT), NTOK, D, D}; pg8::PairOrder S; S.init(NTOK, D, gridDim.x, blockIdx.x);
        pg8::EpiMerge E{(const bf16_t*)(q.ws + OFF_ZG) + 5 * GS, (const bf16_t*)(q.ws + OFF_ZG) + 6 * GS, (bf16_t*)(q.ws + OFF_H)};
        pg8::gemm_phase((LAS unsigned char*)shm, g, S, E); PHASE_END
    PHASE_BEGIN(7) pg8::Gemm g{(const bf16_t*)(q.ws + OFF_H), (const bf16_t*)(q.ws + OFF_WOT), NTOK, D, D}; pg8::StaticOrder S; S.init(NTOK, D, gridDim.x, blockIdx.x);
        pg8::EpiOut E{q.xp, q.xs, (const float*)(q.ws + OFF_MODG), q.out};
        pg8::gemm_phase((LAS unsigned char*)shm, g, S, E); PHASE_END
    PHASE_BEGIN(8) p8_final(q); PHASE_END
}

constexpr int LDS_BYTES = 128 * 1024;

extern "C" void kernel_launch(void* const* d_in, const int* in_sizes, int n_in, void* d_out, int out_size, void* d_ws, size_t ws_size, hipStream_t stream) {
    static int grid = 0;
    if (grid == 0) {
        if (n_in != 26 || ws_size < WS_END) { fprintf(stderr, "kernel_launch: need 26 inputs and %zu bytes of workspace; got %d, %zu\n", (size_t)WS_END, n_in, ws_size); grid = -1; return; }
        int dev = 0, cus = 0, per_cu = 0;
        (void)hipGetDevice(&dev); (void)hipDeviceGetAttribute(&cus, hipDeviceAttributeMultiprocessorCount, dev);
        if (hipFuncSetAttribute((const void*)mega, hipFuncAttributeMaxDynamicSharedMemorySize, LDS_BYTES) != hipSuccess) { fprintf(stderr, "kernel_launch: hipFuncSetAttribute failed\n"); grid = -1; return; }
        if (hipOccupancyMaxActiveBlocksPerMultiprocessor(&per_cu, (const void*)mega, 512, LDS_BYTES) != hipSuccess || per_cu < 1) { fprintf(stderr, "kernel_launch: occupancy query failed (%d)\n", per_cu); (void)hipGetLastError(); per_cu = 1; }
        if (per_cu > 1) per_cu = 1;
        grid = cus * per_cu;
    }
    if (grid < 0) return;
    Params p{};
    const float** pp = (const float**)&p;
    for (int i = 0; i < 26; ++i) pp[i] = (const float*)d_in[i];
    p.out = (float*)d_out; p.ws = (unsigned char*)d_ws;
#if N_LAUNCH_SPLIT
    for (int ph = 0; ph < NPHASE; ++ph) { p.ph_lo = ph; p.ph_hi = ph + 1; hipLaunchKernelGGL(mega, dim3(grid), dim3(512), LDS_BYTES, stream, p); }
#else
    p.ph_lo = 0; p.ph_hi = PH_HI;
    void* args[] = {&p};
    hipError_t e = hipLaunchCooperativeKernel((const void*)mega, dim3(grid), dim3(512), args, LDS_BYTES, stream);
    if (e != hipSuccess) fprintf(stderr, "cooperative launch failed: %s (grid %d)\n", hipGetErrorString(e), grid);
#endif
}
```

```cpp
#include <hip/hip_runtime.h>
#include <hip/hip_cooperative_groups.h>
#include <hip/hip_fp16.h>
#include <cstdio>
#include <cstdint>
namespace cg = cooperative_groups;

#define LAS __attribute__((address_space(3)))
#define GAS __attribute__((address_space(1)))
typedef unsigned short bf16_t;
typedef short bf16x8 __attribute__((ext_vector_type(8)));
typedef float f32x4 __attribute__((ext_vector_type(4)));
typedef float f32x2 __attribute__((ext_vector_type(2)));
typedef unsigned u32x4 __attribute__((ext_vector_type(4)));
typedef unsigned u32x2 __attribute__((ext_vector_type(2)));

#ifndef EXP_CTX
#define EXP_CTX 1
#endif
#ifndef EXP_LAT
#define EXP_LAT 1
#endif
#ifndef EXP_ST
#define EXP_ST 1
#endif
#ifndef DUP_MASK
#define DUP_MASK 0
#endif
#ifndef PH_HI
#define PH_HI NPHASE
#endif
#ifndef N_LAUNCH_SPLIT
#define N_LAUNCH_SPLIT 0
#endif

constexpr int D = 2048, NTOK = 8192, NCTX = 4096, DIN = 20864, NPAD = 20992, NSH = 6528;
constexpr int NPHASE = 9;
constexpr size_t GS = (size_t)NTOK * D;
constexpr size_t OFF_WINT = 0;
constexpr size_t SZ_WINT = (size_t)NPAD * D * 2;
constexpr size_t OFF_WABT = OFF_WINT + SZ_WINT;
constexpr size_t OFF_WOT = OFF_WABT + (size_t)4096 * D * 2;
constexpr size_t OFF_LT = OFF_WOT + (size_t)D * D * 2;
constexpr size_t OFF_MODP = OFF_LT + (size_t)4 * D * 96 * 2;
constexpr size_t OFF_MODG = OFF_MODP + (size_t)16 * 5 * 6144 * 4;
constexpr size_t OFF_BS = OFF_MODG + (size_t)5 * 2048 * 4;
constexpr size_t OFF_H = OFF_BS + (size_t)2 * NTOK * 32 * 4;
constexpr size_t OFF_ZR = OFF_H + GS * 2;
constexpr size_t OFF_ZWD = OFF_ZR + 3 * GS * 2;
constexpr size_t OFF_ZG = OFF_ZWD + (size_t)NTOK * 512 * 2;
constexpr size_t OFF_LAM = OFF_ZG + 7 * GS * 2;
constexpr size_t OFF_PSLOT = OFF_LAM + 4 * GS * 2;
constexpr size_t WS_END = OFF_PSLOT + 1024 * 256;
constexpr size_t OFF_YDIR = OFF_ZG + 1 * GS * 2;

struct Params {
    const float *xp, *xs, *st_f, *st_b, *c, *c_ctx, *ada_w, *ada_b, *norm_g, *w_in, *mu_prev, *mu_next, *w0, *w2, *a0, *a2, *k_k, *k_a, *r_k, *lnx_g, *lnx_b, *conv_w, *w_out_a, *w_out_b, *w_o, *final_g;
    float* out; unsigned char* ws;
    int ph_lo, ph_hi;
};

template <class T> __device__ __forceinline__ T* as_global(T* p) { return (T*)(GAS T*)p; }
__device__ __forceinline__ Params load_params(const Params* slot) {
    Params q; { const GAS unsigned long long* s_ = (const GAS unsigned long long*)slot; unsigned long long* d_ = (unsigned long long*)&q; for (int i = 0; i < 29; ++i) d_[i] = s_[i]; }
    q.xp = as_global(q.xp); q.xs = as_global(q.xs); q.st_f = as_global(q.st_f); q.st_b = as_global(q.st_b); q.c = as_global(q.c); q.c_ctx = as_global(q.c_ctx); q.ada_w = as_global(q.ada_w); q.ada_b = as_global(q.ada_b);
    q.norm_g = as_global(q.norm_g); q.w_in = as_global(q.w_in); q.mu_prev = as_global(q.mu_prev); q.mu_next = as_global(q.mu_next); q.w0 = as_global(q.w0); q.w2 = as_global(q.w2); q.a0 = as_global(q.a0); q.a2 = as_global(q.a2);
    q.k_k = as_global(q.k_k); q.k_a = as_global(q.k_a); q.r_k = as_global(q.r_k); q.lnx_g = as_global(q.lnx_g); q.lnx_b = as_global(q.lnx_b); q.conv_w = as_global(q.conv_w); q.w_out_a = as_global(q.w_out_a); q.w_out_b = as_global(q.w_out_b);
    q.w_o = as_global(q.w_o); q.final_g = as_global(q.final_g); q.out = as_global(q.out); q.ws = as_global(q.ws);
    return q;
}
__device__ __forceinline__ unsigned pk2(float lo, float hi) { unsigned r; asm("v_cvt_pk_bf16_f32 %0, %1, %2" : "=v"(r) : "v"(lo), "v"(hi)); return r; }
__device__ __forceinline__ float bflo(unsigned u) { return __uint_as_float(u << 16); }
__device__ __forceinline__ float bfhi(unsigned u) { return __uint_as_float(u & 0xffff0000u); }
__device__ __forceinline__ float bf1(bf16_t u) { return __uint_as_float(((unsigned)u) << 16); }
__device__ __forceinline__ float sigm(float x) { return 1.f / (1.f + __expf(-x)); }
__device__ __forceinline__ float wave_sum(float v) {
#pragma unroll
    for (int o = 1; o < 64; o <<= 1) v += __shfl_xor(v, o);
    return v;
}
__device__ __forceinline__ float quad_sum(float v) {
    v += __int_as_float(__builtin_amdgcn_update_dpp(0, __float_as_int(v), 0xB1, 0xF, 0xF, true));
    v += __int_as_float(__builtin_amdgcn_update_dpp(0, __float_as_int(v), 0x4E, 0xF, 0xF, true));
    return v;
}
__device__ __forceinline__ void unpack8(const u32x4 u, float (&f)[8]) {
    f[0] = bflo(u.x); f[1] = bfhi(u.x); f[2] = bflo(u.y); f[3] = bfhi(u.y); f[4] = bflo(u.z); f[5] = bfhi(u.z); f[6] = bflo(u.w); f[7] = bfhi(u.w);
}

namespace pg8 {
constexpr int BM = 256, BK = 64, HALF = 128, HTB = HALF * BK * 2, STAGE_BYTES = 8 * HTB, NXCD = 8, WGM = 8;
__host__ __device__ __forceinline__ int lds_byte(int r, int c) { const int st = (r >> 4) * 2 + (c >> 5), rr = r & 15, cc = c & 31, ob = rr * 64 + cc * 2; return st * 1024 + (ob ^ (((ob >> 9) & 1) << 5)); }
__host__ __device__ __forceinline__ void stage_rc(int b, int& R, int& C) { const int st = b / 1024, sb = b % 1024, swz = sb ^ (((sb >> 9) & 1) << 5); R = (st >> 1) * 16 + swz / 64; C = (st & 1) * 32 + (swz % 64) / 2; }
__host__ __device__ __forceinline__ int perm32(int rho) { const int n = rho >> 4, i = rho & 15; return 8 * (i >> 2) + 4 * n + (i & 3); }
struct Unit { int pm, pn; };
struct Gemm { const bf16_t* A; const bf16_t* Bt; int M, N, K; };

__device__ __forceinline__ void tile_of(int wgid, int nM, int nN, Unit& u) {
    const int nwg = nM * nN;
    { const int q = nwg / NXCD, r = nwg % NXCD, xcd = wgid % NXCD, off = wgid / NXCD; wgid = (xcd < r ? xcd * (q + 1) : r * (q + 1) + (xcd - r) * q) + off; }
    const int nig = WGM * nN, gid = wgid / nig, fm = gid * WGM, gsz = (nM - fm) < WGM ? (nM - fm) : WGM;
    u.pm = fm + ((wgid % nig) % gsz); u.pn = (wgid % nig) / gsz;
}
struct StaticOrder {
    int nM, nN, nwg, G, c;
    __device__ void init(int M, int N, int G_, int c_) { nM = M / BM; nN = N / BM; nwg = nM * nN; G = G_; c = c_; }
    __device__ bool next(int i, Unit& u) const { const long L = (long)i * G + c; if (L >= nwg) return false; tile_of((int)L, nM, nN, u); return true; }
};
struct PairOrder {
    int nM, nN, nwg, G, c;
    __device__ void init(int M, int N, int G_, int c_) { nM = M / BM; nN = N / BM; nwg = nM * nN; G = G_; c = c_; }
    __device__ bool next(int i, Unit& u) const { const long L = (long)(i >> 1) * G + c; if (L >= nwg) return false; tile_of((int)L, nM, nN, u); if (i & 1) { u.pm += nM; u.pn += nN; } return true; }
};

template <class Epi, class Sched>
__device__ __forceinline__ void gemm_phase(LAS unsigned char* lds, const Gemm g, const Sched& S, const Epi& E) {
    const int tid = threadIdx.x, wid = __builtin_amdgcn_readfirstlane(tid >> 6), lane = tid & 63, wr = wid >> 2, wc = wid & 3, fr = lane & 15, fq = lane >> 4;
    const int K = g.K, nt = K / BK;
    unsigned voffA[2], voffB[2];
#pragma unroll
    for (int i = 0; i < 2; ++i) { int R, C; stage_rc(tid * 16 + i * 8192, R, C); const int Rb = Epi::PERM ? ((R & ~31) + perm32(R & 31)) : R;
        voffA[i] = (unsigned)(R * K + C) * 2u; voffB[i] = (unsigned)(Rb * K + C) * 2u; }
    const size_t kstep = (size_t)(BK * 2);
    const size_t hstep = (size_t)HALF * K * 2;
    const size_t tstep = 2 * hstep;
    const unsigned ldsw = (unsigned)wid * 1024u;
    const int aoff = lds_byte(wr * 64 + fr, fq * 8), boff = lds_byte(wc * 32 + fr, fq * 8);
#define PG8_SA(b, h) (((b) * 2 + (h)) * HTB)
#define PG8_SB(b, h) ((4 + (b) * 2 + (h)) * HTB)
#define PG8_STAGE(bufoff, gbase, voff) do { _Pragma("unroll") for (int _i = 0; _i < 2; ++_i) \
        __builtin_amdgcn_global_load_lds((const unsigned*)((const char*)(gbase) + (voff)[_i]), (LAS unsigned*)(lds + (bufoff) + ldsw + _i * 8192), 16, 0, 0); } while (0)
#define PG8_LDA(dst, b, h) do { _Pragma("unroll") for (int m = 0; m < 4; ++m) _Pragma("unroll") for (int k = 0; k < 2; ++k) dst[m][k] = *(const LAS bf16x8*)(lds + PG8_SA(b, h) + aoff + m * 2048 + k * 1024); } while (0)
#define PG8_LDB(dst, b, h) do { _Pragma("unroll") for (int n = 0; n < 2; ++n) _Pragma("unroll") for (int k = 0; k < 2; ++k) dst[n][k] = *(const LAS bf16x8*)(lds + PG8_SB(b, h) + boff + n * 2048 + k * 1024); } while (0)
#define PG8_MMA(ai, bj, At, Bt) do { __builtin_amdgcn_s_setprio(1); _Pragma("unroll") for (int m = 0; m < 4; ++m) _Pragma("unroll") for (int n = 0; n < 2; ++n) _Pragma("unroll") for (int k = 0; k < 2; ++k) \
        acc[ai][bj][m][n] = __builtin_amdgcn_mfma_f32_16x16x32_bf16(Bt[n][k], At[m][k], acc[ai][bj][m][n], 0, 0, 0); __builtin_amdgcn_s_setprio(0); } while (0)
#define PG8_WAIT_V(n) asm volatile("s_waitcnt vmcnt(" #n ")" ::: "memory")
#define PG8_WAIT_L(n) asm volatile("s_waitcnt lgkmcnt(" #n ")" ::: "memory")
#define PG8_BAR __builtin_amdgcn_s_barrier()
#define PG8_SCHED __builtin_amdgcn_sched_barrier(0)
    Unit cur, nxt; int ui = 0;
    if (!S.next(0, cur)) return;
    f32x4 acc[2][2][4][2];
#pragma unroll
    for (int a = 0; a < 2; ++a)
#pragma unroll
        for (int b = 0; b < 2; ++b)
#pragma unroll
            for (int m = 0; m < 4; ++m)
#pragma unroll
                for (int n = 0; n < 2; ++n) acc[a][b][m][n] = (f32x4){0.f, 0.f, 0.f, 0.f};
    bf16x8 At[4][2], B0[2][2], B1[2][2];
    const char* cA = (const char*)g.A + (size_t)cur.pm * tstep; const char* cB = (const char*)g.Bt + (size_t)cur.pn * tstep;
    PG8_STAGE(PG8_SB(0, 0), cB, voffB); PG8_STAGE(PG8_SA(0, 0), cA, voffA); PG8_STAGE(PG8_SB(0, 1), cB + hstep, voffB); PG8_STAGE(PG8_SA(0, 1), cA + hstep, voffA);
    if (wr == 1) PG8_BAR;
    PG8_WAIT_V(4); PG8_BAR;
    PG8_STAGE(PG8_SB(1, 0), cB + kstep, voffB); PG8_STAGE(PG8_SA(1, 0), cA + kstep, voffA); PG8_STAGE(PG8_SB(1, 1), cB + hstep + kstep, voffB);
    PG8_WAIT_V(6); PG8_BAR;
    for (;;) {
        const bool has_next = S.next(ui + 1, nxt);
        const char* nA = has_next ? (const char*)g.A + (size_t)nxt.pm * tstep : cA; const char* nB = has_next ? (const char*)g.Bt + (size_t)nxt.pn * tstep : cB;
        for (int t = 0; t < nt; t += 2) {
            const bool last = (t == nt - 2);
            const char* a1 = cA + (size_t)(t + 1) * kstep;
            const char* a2 = last ? nA : cA + (size_t)(t + 2) * kstep; const char* b2 = last ? nB : cB + (size_t)(t + 2) * kstep;
            const char* a3 = a2 + kstep; const char* b3 = b2 + kstep;
            PG8_LDB(B0, 0, 0); PG8_SCHED; PG8_LDA(At, 0, 0); PG8_STAGE(PG8_SA(1, 1), a1 + hstep, voffA);
            PG8_WAIT_L(8); PG8_BAR; PG8_WAIT_L(0); PG8_MMA(0, 0, At, B0); PG8_BAR; PG8_SCHED;
            PG8_LDB(B1, 0, 1); PG8_STAGE(PG8_SB(0, 0), b2, voffB);
            PG8_BAR; PG8_WAIT_L(0); PG8_MMA(0, 1, At, B1); PG8_BAR;
            PG8_LDA(At, 0, 1); PG8_STAGE(PG8_SA(0, 0), a2, voffA);
            PG8_BAR; PG8_WAIT_L(0); PG8_MMA(1, 0, At, B0); PG8_BAR; PG8_SCHED;
            PG8_STAGE(PG8_SB(0, 1), b2 + hstep, voffB);
            PG8_WAIT_V(6); PG8_BAR; PG8_MMA(1, 1, At, B1); PG8_BAR;
            PG8_LDB(B0, 1, 0); PG8_SCHED; PG8_LDA(At, 1, 0); PG8_STAGE(PG8_SA(0, 1), a2 + hstep, voffA);
            PG8_WAIT_L(8); PG8_BAR; PG8_WAIT_L(0); PG8_MMA(0, 0, At, B0); PG8_BAR; PG8_SCHED;
            PG8_LDB(B1, 1, 1); PG8_STAGE(PG8_SB(1, 0), b3, voffB);
            PG8_BAR; PG8_WAIT_L(0); PG8_MMA(0, 1, At, B1); PG8_BAR;
            PG8_LDA(At, 1, 1); PG8_STAGE(PG8_SA(1, 0), a3, voffA);
            PG8_BAR; PG8_WAIT_L(0); PG8_MMA(1, 0, At, B0); PG8_BAR; PG8_SCHED;
            PG8_STAGE(PG8_SB(1, 1), b3 + hstep, voffB);
            PG8_WAIT_V(6); PG8_BAR; PG8_MMA(1, 1, At, B1); PG8_BAR;
        }
        const bool keep = E(acc, cur, wr, wc, fr, fq);
        if (!has_next) break;
        if (!keep) {
#pragma unroll
            for (int a = 0; a < 2; ++a)
#pragma unroll
                for (int b = 0; b < 2; ++b)
#pragma unroll
                    for (int m = 0; m < 4; ++m)
#pragma unroll
                        for (int n = 0; n < 2; ++n) acc[a][b][m][n] = (f32x4){0.f, 0.f, 0.f, 0.f};
        }
        cur = nxt; cA = nA; cB = nB; ++ui;
    }
    PG8_WAIT_V(0);
    if (wr == 0) PG8_BAR;
    PG8_BAR;
#undef PG8_SA
#undef PG8_SB
#undef PG8_STAGE
#undef PG8_LDA
#undef PG8_LDB
#undef PG8_MMA
#undef PG8_WAIT_V
#undef PG8_WAIT_L
#undef PG8_BAR
#undef PG8_SCHED
}

struct EpiZ {
    static constexpr bool PERM = true;
    unsigned char* ws;
    __device__ __forceinline__ bool operator()(f32x4 (&acc)[2][2][4][2], const Unit& u, int wr, int wc, int fr, int fq) const {
        bf16_t* base; int ld, colt;
        if (u.pn < 24) { base = (bf16_t*)(ws + OFF_ZR) + (size_t)(u.pn >> 3) * GS; ld = D; colt = (u.pn & 7) * 256; }
        else if (u.pn < 26) { base = (bf16_t*)(ws + OFF_ZWD); ld = 512; colt = (u.pn - 24) * 256; }
        else { const int q = u.pn - 26; base = (bf16_t*)(ws + OFF_ZG) + (size_t)(q >> 3) * GS; ld = D; colt = (q & 7) * 256; }
        const int row0 = u.pm * BM + wr * 64 + fr, col0 = colt + wc * 32 + 8 * fq;
#pragma unroll
        for (int ai = 0; ai < 2; ++ai)
#pragma unroll
            for (int m = 0; m < 4; ++m) { bf16_t* rowp = base + (size_t)(row0 + ai * HALF + m * 16) * ld + col0;
#pragma unroll
                for (int bj = 0; bj < 2; ++bj) { const f32x4 v0 = acc[ai][bj][m][0], v1 = acc[ai][bj][m][1];
                    u32x4 w; w.x = pk2(v0[0], v0[1]); w.y = pk2(v0[2], v0[3]); w.z = pk2(v1[0], v1[1]); w.w = pk2(v1[2], v1[3]);
                    *(u32x4*)(rowp + bj * HALF) = w; } }
        return false;
    }
};
struct EpiMerge {
    static constexpr bool PERM = true;
    const bf16_t *ma, *mb; bf16_t* out;
    __device__ __forceinline__ bool operator()(f32x4 (&acc)[2][2][4][2], const Unit& u, int wr, int wc, int fr, int fq) const {
        const bool isb = u.pm >= 32; const int pm = isb ? u.pm - 32 : u.pm, pn = isb ? u.pn - 8 : u.pn;
        const int row0 = pm * BM + wr * 64 + fr, col0 = pn * BM + wc * 32 + 8 * fq;
#pragma unroll
        for (int ai = 0; ai < 2; ++ai)
#pragma unroll
            for (int m = 0; m < 4; ++m) { const size_t ro = (size_t)(row0 + ai * HALF + m * 16) * D + col0;
#pragma unroll
                for (int bj = 0; bj < 2; ++bj) {
                    float fb[8]; unpack8(*(const u32x4*)(mb + ro + bj * HALF), fb);
                    if (!isb) {
                        float fa[8]; unpack8(*(const u32x4*)(ma + ro + bj * HALF), fa);
#pragma unroll
                        for (int j = 0; j < 4; ++j) { acc[ai][bj][m][0][j] *= (1.f + __expf(-fb[j])) / (1.f + __expf(-fa[j])); acc[ai][bj][m][1][j] *= (1.f + __expf(-fb[4 + j])) / (1.f + __expf(-fa[4 + j])); }
                    } else {
                        f32x4 v0 = acc[ai][bj][m][0], v1 = acc[ai][bj][m][1];
#pragma unroll
                        for (int j = 0; j < 4; ++j) { v0[j] *= sigm(fb[j]); v1[j] *= sigm(fb[4 + j]); }
                        u32x4 w; w.x = pk2(v0[0], v0[1]); w.y = pk2(v0[2], v0[3]); w.z = pk2(v1[0], v1[1]); w.w = pk2(v1[2], v1[3]);
                        *(u32x4*)(out + ro + bj * HALF) = w;
                    } } }
        return !isb;
    }
};
struct EpiOut {
    static constexpr bool PERM = false;
    const float *xp, *xs, *modg; float* out;
    __device__ __forceinline__ bool operator()(f32x4 (&acc)[2][2][4][2], const Unit& u, int wr, int wc, int fr, int fq) const {
        const int row0 = u.pm * BM + wr * 64 + fr, col0 = u.pn * BM + wc * 32 + 4 * fq;
        const int mi = (u.pm < 16) ? 0 : 1 + ((u.pm - 16) >> 2);
        f32x4 gv[2][2];
#pragma unroll
        for (int bj = 0; bj < 2; ++bj)
#pragma unroll
            for (int n = 0; n < 2; ++n) gv[bj][n] = *(const f32x4*)(modg + mi * 2048 + col0 + bj * HALF + n * 16);
#pragma unroll
        for (int ai = 0; ai < 2; ++ai)
#pragma unroll
            for (int m = 0; m < 4; ++m) { const int row = row0 + ai * HALF + m * 16;
                const float* xr = (row < NCTX ? xp + (size_t)row * D : xs + (size_t)(row - NCTX) * D) + col0; float* orow = out + (size_t)row * D + col0;
#pragma unroll
                for (int bj = 0; bj < 2; ++bj)
#pragma unroll
                    for (int n = 0; n < 2; ++n) { const f32x4 xv = *(const f32x4*)(xr + bj * HALF + n * 16); *(f32x4*)(orow + bj * HALF + n * 16) = xv + gv[bj][n] * acc[ai][bj][m][n]; } }
        return false;
    }
};
}

__device__ __forceinline__ void transpose_item(const float* W, int N, bf16_t* WT, int K, int item, int nblk, float* scr, int lane, int pad_from, int pad_amt) {
    const int kb = item / nblk, nb = item % nblk, k0 = 64 * kb, n0 = 32 * nb;
#pragma unroll
    for (int i = 0; i < 8; ++i) { const int kk = 8 * i + (lane >> 3); const f32x4 v = *(const f32x4*)(W + (size_t)(k0 + kk) * N + n0 + 4 * (lane & 7)); float* d = scr + kk * 33 + 4 * (lane & 7);
        d[0] = v.x; d[1] = v.y; d[2] = v.z; d[3] = v.w; }
    asm volatile("s_waitcnt lgkmcnt(0)" ::: "memory");
    const int c = lane & 7; const int roff = (n0 >= pad_from) ? pad_amt : 0;
#pragma unroll
    for (int j = 0; j < 4; ++j) { const int n = (lane >> 3) + 8 * j; const float* s = scr + (8 * c) * 33 + n;
        u32x4 o; o.x = pk2(s[0 * 33], s[1 * 33]); o.y = pk2(s[2 * 33], s[3 * 33]); o.z = pk2(s[4 * 33], s[5 * 33]); o.w = pk2(s[6 * 33], s[7 * 33]);
        *(u32x4*)(WT + (size_t)(roff + n0 + n) * K + k0 + 8 * c) = o; }
    asm volatile("s_waitcnt lgkmcnt(0)" ::: "memory");
}
__device__ __forceinline__ void p0_prep(const Params& p, float* ldsf) {
    const int tid = threadIdx.x, lane = tid & 63, wave = tid >> 6, G = gridDim.x;
    float* modp = (float*)(p.ws + OFF_MODP);
    for (int u = blockIdx.x; u < 48; u += G) {
        const int cg3 = u % 3, ks = u / 3, k0 = ks * 128;
        __syncthreads();
        for (int i = tid; i < 5 * 128; i += 512) { const int mi = i >> 7, k = i & 127; const float* cv = mi == 0 ? p.c_ctx : p.c + (mi - 1) * 2048; const float x = cv[k0 + k]; ldsf[i] = x / (1.f + __expf(-x)); }
        __syncthreads();
        const int c0 = cg3 * 2048 + 4 * tid;
        f32x4 a0 = {0.f, 0.f, 0.f, 0.f}, a1 = a0, a2 = a0, a3 = a0, a4 = a0;
#pragma unroll 8
        for (int k = 0; k < 128; ++k) { const f32x4 w = *(const f32x4*)(p.ada_w + (size_t)(k0 + k) * 6144 + c0);
            a0 += ldsf[k] * w; a1 += ldsf[128 + k] * w; a2 += ldsf[256 + k] * w; a3 += ldsf[384 + k] * w; a4 += ldsf[512 + k] * w; }
        float* o = modp + (size_t)(ks * 5) * 6144 + c0;
        *(f32x4*)(o) = a0; *(f32x4*)(o + 6144) = a1; *(f32x4*)(o + 2 * 6144) = a2; *(f32x4*)(o + 3 * 6144) = a3; *(f32x4*)(o + 4 * 6144) = a4;
    }
    __syncthreads();
    float* scr = ldsf + wave * (64 * 33);
    bf16_t* WinT = (bf16_t*)(p.ws + OFF_WINT); bf16_t* WabT = (bf16_t*)(p.ws + OFF_WABT); bf16_t* WoT = (bf16_t*)(p.ws + OFF_WOT); bf16_t* LT = (bf16_t*)(p.ws + OFF_LT);
    constexpr int I_IN = 32 * (DIN / 32), I_SQ = 32 * 64, NITEMS = I_IN + 3 * I_SQ + 128 + 128;
    for (int it = blockIdx.x * 8 + wave; it < NITEMS; it += G * 8) {
        int r = it;
        if (r < I_IN) { transpose_item(p.w_in, DIN, WinT, D, r, DIN / 32, scr, lane, NSH, 128); continue; } r -= I_IN;
        if (r < I_SQ) { transpose_item(p.w_out_a, D, WabT, D, r, 64, scr, lane, 1 << 30, 0); continue; } r -= I_SQ;
        if (r < I_SQ) { transpose_item(p.w_out_b, D, WabT + (size_t)D * D, D, r, 64, scr, lane, 1 << 30, 0); continue; } r -= I_SQ;
        if (r < I_SQ) { transpose_item(p.w_o, D, WoT, D, r, 64, scr, lane, 1 << 30, 0); continue; } r -= I_SQ;
        if (r < 128) {
            u32x4 z = {0u, 0u, 0u, 0u}; bf16_t* row = WinT + (size_t)(NSH + r) * D;
#pragma unroll
            for (int j = 0; j < 4; ++j) *(u32x4*)(row + (lane + 64 * j) * 8) = z;
            continue; }
        r -= 128;
        { const int m = r >> 5, n = (r & 31) * 64 + lane; const float* src = ((m >> 1) ? p.a2 : p.w2) + (size_t)(m & 1) * 96 * 2048 + n;
#pragma unroll 4
            for (int kc = 0; kc < 12; ++kc) { const float* s = src + (size_t)(8 * kc) * 2048;
                u32x4 o; o.x = pk2(s[0], s[2048]); o.y = pk2(s[2 * 2048], s[3 * 2048]); o.z = pk2(s[4 * 2048], s[5 * 2048]); o.w = pk2(s[6 * 2048], s[7 * 2048]);
                *(u32x4*)(LT + ((size_t)(m * 3 + (kc >> 2)) * 2048 + n) * 32 + 8 * (kc & 3)) = o; } }
    }
}

__device__ __forceinline__ void p1_norm(const Params& p, float* ldsf) {
    const int tid = threadIdx.x, lane = tid & 63, wave = tid >> 6, G = gridDim.x;
    const float* modp = (const float*)(p.ws + OFF_MODP); float* modg = (float*)(p.ws + OFF_MODG); bf16_t* H = (bf16_t*)(p.ws + OFF_H);
    for (int mi = blockIdx.x; mi < 5; mi += G) {
        const int c4 = 4 * tid; f32x4 g = *(const f32x4*)(p.ada_b + 4096 + c4);
        for (int ks = 0; ks < 16; ++ks) g += *(const f32x4*)(modp + (size_t)(ks * 5 + mi) * 6144 + 4096 + c4);
        *(f32x4*)(modg + mi * 2048 + c4) = g;
    }
    for (int ch = blockIdx.x; ch < 256; ch += G) {
        const int t0 = ch * 32, mi = t0 < NCTX ? 0 : 1 + ((t0 - NCTX) >> 10);
        __syncthreads();
        { const int c4 = 4 * tid; f32x4 sh = *(const f32x4*)(p.ada_b + c4), sc = *(const f32x4*)(p.ada_b + 2048 + c4);
            for (int ks = 0; ks < 16; ++ks) { const float* m = modp + (size_t)(ks * 5 + mi) * 6144 + c4; sh += *(const f32x4*)m; sc += *(const f32x4*)(m + 2048); }
            *(f32x4*)(ldsf + c4) = sh; *(f32x4*)(ldsf + 2048 + c4) = sc + 1.f; }
        __syncthreads();
        for (int i = 0; i < 4; ++i) {
            const int t = t0 + wave * 4 + i; const float* xr = t < NCTX ? p.xp + (size_t)t * D : p.xs + (size_t)(t - NCTX) * D;
            f32x4 v[8]; float ss = 0.f;
#pragma unroll
            for (int j = 0; j < 8; ++j) { v[j] = *(const f32x4*)(xr + 4 * lane + 256 * j); ss += (v[j].x * v[j].x + v[j].y * v[j].y) + (v[j].z * v[j].z + v[j].w * v[j].w); }
            const float rstd = rsqrtf(wave_sum(ss) * (1.f / D) + 1e-6f);
#pragma unroll
            for (int j = 0; j < 8; ++j) { const int c = 4 * lane + 256 * j; const f32x4 g = *(const f32x4*)(p.norm_g + c), sh = *(const f32x4*)(ldsf + c), sc = *(const f32x4*)(ldsf + 2048 + c);
                const f32x4 hv = (v[j] * rstd * g) * sc + sh; u32x2 o; o.x = pk2(hv.x, hv.y); o.y = pk2(hv.z, hv.w);
                *(u32x2*)(H + (size_t)t * D + c) = o; }
        }
    }
}

__device__ __forceinline__ void p3_lora_conv(const Params& p) {
    const int tid = threadIdx.x, lane = tid & 63, wave = tid >> 6, G = gridDim.x, fr = lane & 15, fq = lane >> 4;
    const bf16_t* zwd = (const bf16_t*)(p.ws + OFF_ZWD); const bf16_t* LT = (const bf16_t*)(p.ws + OFF_LT);
    __half* LAM = (__half*)(p.ws + OFF_LAM);
    for (int u = blockIdx.x * 8 + wave; u < 2048; u += G * 8) {
        const int mt = u >> 2, nq = u & 3, t = mt * 16 + fr;
        const int L = t < NCTX ? 256 : 1024, tau = t & (L - 1);
        const bool hp = tau != 0, hn = tau != L - 1;
        bf16x8 af[4][3];
#pragma unroll
        for (int m = 0; m < 4; ++m)
#pragma unroll
            for (int ks = 0; ks < 3; ++ks) {
                const int c = m * 96 + 32 * ks + 8 * fq;
                const u32x4 zc = *(const u32x4*)(zwd + (size_t)t * 512 + c);
                u32x4 zp = {0u, 0u, 0u, 0u}, zn = {0u, 0u, 0u, 0u};
                if (hp) zp = *(const u32x4*)(zwd + (size_t)(t - 1) * 512 + c);
                if (hn) zn = *(const u32x4*)(zwd + (size_t)(t + 1) * 512 + c);
                float fc[8], fp[8], fn[8]; unpack8(zc, fc); unpack8(zp, fp); unpack8(zn, fn);
                const f32x4 mp0 = *(const f32x4*)(p.mu_prev + 6144 + c), mp1 = *(const f32x4*)(p.mu_prev + 6144 + c + 4), mn0 = *(const f32x4*)(p.mu_next + 6144 + c), mn1 = *(const f32x4*)(p.mu_next + 6144 + c + 4);
                float o[8];
#pragma unroll
                for (int j = 0; j < 8; ++j) { const float mp = j < 4 ? mp0[j & 3] : mp1[j & 3], mn = j < 4 ? mn0[j & 3] : mn1[j & 3];
                    float zsv = fc[j] + mp * (fp[j] - fc[j]) + mn * (fn[j] - fc[j]);
                    if (m < 2) zsv = 1.f - 2.f / (1.f + __expf(2.f * zsv));
                    o[j] = zsv; }
                u32x4 pk; pk.x = pk2(o[0], o[1]); pk.y = pk2(o[2], o[3]); pk.z = pk2(o[4], o[5]); pk.w = pk2(o[6], o[7]);
                af[m][ks] = __builtin_bit_cast(bf16x8, pk);
            }
        for (int ng = 0; ng < 8; ++ng) {
            const int n0 = nq * 512 + ng * 64;
#pragma unroll
            for (int m = 0; m < 4; ++m) {
                f32x4 acc[4];
#pragma unroll
                for (int nt = 0; nt < 4; ++nt) { acc[nt] = (f32x4){0.f, 0.f, 0.f, 0.f};
                    const int rho = (nt & 1) * 16 + fr, chn = n0 + 32 * (nt >> 1) + 8 * ((rho & 15) >> 2) + 4 * (rho >> 4) + (rho & 3);
#pragma unroll
                    for (int ks = 0; ks < 3; ++ks) { const bf16x8 bw = *(const bf16x8*)(LT + ((size_t)(m * 3 + ks) * 2048 + chn) * 32 + 8 * fq);
                        acc[nt] = __builtin_amdgcn_mfma_f32_16x16x32_bf16(bw, af[m][ks], acc[nt], 0, 0, 0); } }
                const int dir = m & 1, kind = m >> 1; const float* bias = (kind ? p.a0 : p.w0) + dir * 2048;
#pragma unroll
                for (int np = 0; np < 2; ++np) { const int ch = n0 + 32 * np + 8 * fq; const f32x4 bv0 = *(const f32x4*)(bias + ch), bv1 = *(const f32x4*)(bias + ch + 4);
                    float r[8];
#pragma unroll
                    for (int j = 0; j < 4; ++j) { const float s0 = sigm(bv0[j] + acc[2 * np][j]), s1 = sigm(bv1[j] + acc[2 * np + 1][j]); r[j] = kind ? s0 : 0.60653066f * s0; r[4 + j] = kind ? s1 : 0.60653066f * s1; }
                    const __half2 h0 = __floats2half2_rn(r[0], r[1]), h1 = __floats2half2_rn(r[2], r[3]), h2 = __floats2half2_rn(r[4], r[5]), h3 = __floats2half2_rn(r[6], r[7]);
                    u32x4 o; o.x = __builtin_bit_cast(unsigned, h0); o.y = __builtin_bit_cast(unsigned, h1); o.z = __builtin_bit_cast(unsigned, h2); o.w = __builtin_bit_cast(unsigned, h3);
                    *(u32x4*)(LAM + (size_t)(kind * 2 + dir) * GS + (size_t)t * D + ch) = o; }
            }
        }
    }
    const bf16_t* zbg = (const bf16_t*)(p.ws + OFF_ZG) + 1 * GS; const bf16_t* zcg = zbg + GS; const bf16_t* zxb = zcg + GS; const bf16_t* zgb = zxb + GS;
    bf16_t* yb = (bf16_t*)(p.ws + OFF_WINT) + GS;
    for (int i = blockIdx.x * 512 + tid; i < NTOK * 256; i += G * 512) {
        const int t = i >> 8, c = (i & 255) * 8;
        const int Lr = t < NCTX ? 256 : 64, pos = t & (Lr - 1);
        const size_t o = (size_t)t * D + c;
        float cgc[8], xbc[8], pc[8], pp[8], pn[8];
        unpack8(*(const u32x4*)(zcg + o), cgc); unpack8(*(const u32x4*)(zxb + o), xbc);
#pragma unroll
        for (int j = 0; j < 8; ++j) { pc[j] = cgc[j] * xbc[j]; pp[j] = 0.f; pn[j] = 0.f; }
        if (pos != 0) { unpack8(*(const u32x4*)(zcg + o - D), cgc); unpack8(*(const u32x4*)(zxb + o - D), xbc);
#pragma unroll
            for (int j = 0; j < 8; ++j) pp[j] = cgc[j] * xbc[j]; }
        if (pos != Lr - 1) { unpack8(*(const u32x4*)(zcg + o + D), cgc); unpack8(*(const u32x4*)(zxb + o + D), xbc);
#pragma unroll
            for (int j = 0; j < 8; ++j) pn[j] = cgc[j] * xbc[j]; }
        float bg[8], gb[8]; unpack8(*(const u32x4*)(zbg + o), bg); unpack8(*(const u32x4*)(zgb + o), gb);
        float r[8];
#pragma unroll
        for (int j = 0; j < 8; ++j) { const float w0 = p.conv_w[c + j], w1 = p.conv_w[2048 + c + j], w2 = p.conv_w[4096 + c + j];
            const float uu = w0 * pp[j] + w1 * pc[j] + w2 * pn[j]; r[j] = bg[j] * uu * (gb[j] / (1.f + __expf(-gb[j]))); }
        u32x4 w; w.x = pk2(r[0], r[1]); w.y = pk2(r[2], r[3]); w.z = pk2(r[4], r[5]); w.w = pk2(r[6], r[7]);
        *(u32x4*)(yb + o) = w;
    }
}

__device__ __forceinline__ float dpp_add(float v, const int ctrl_unused) { return v; }
#define DPP_ADD(v, ctrl, rmask) ((v) + __int_as_float(__builtin_amdgcn_update_dpp(0, __float_as_int(v), (ctrl), (rmask), 0xF, false)))
__device__ __forceinline__ float oct_sum(float v) { v = DPP_ADD(v, 0xB1, 0xF); v = DPP_ADD(v, 0x4E, 0xF); v = DPP_ADD(v, 0x141, 0xF); return v; }
__device__ __forceinline__ float wave_sum_u(float v) {
    v = DPP_ADD(v, 0xB1, 0xF); v = DPP_ADD(v, 0x4E, 0xF); v = DPP_ADD(v, 0x141, 0xF); v = DPP_ADD(v, 0x140, 0xF);
    v = DPP_ADD(v, 0x142, 0xA); v = DPP_ADD(v, 0x143, 0xC);
    return __int_as_float(__builtin_amdgcn_readlane(__float_as_int(v), 63));
}
constexpr int CT = 16, CBUF = CT * 384;
struct ScanRaw { unsigned short r[6], k[6], v[6]; __half lam[4], av[4]; };
struct ScanCtx {
    const bf16_t *zr, *zk, *zv; const __half *lamd, *avd; float* bs;
    int h, dir, lane, wq, c;
    float mpr, mnr, mpk, mnk, mpv, mnv, kkc, kac, rkc;
};
__device__ __forceinline__ void scan_load(const ScanCtx& X, int seqbase, int L, int lo, ScanRaw& R) {
    const int tau0 = lo + 4 * X.wq;
#pragma unroll
    for (int x = 0; x < 6; ++x) { const int t = tau0 - 1 + x; const bool ok = (t >= 0) && (t < L); const size_t off = (size_t)(seqbase + (ok ? t : tau0)) * D + X.c;
        const unsigned short a = X.zr[off], b = X.zk[off], cc = X.zv[off]; R.r[x] = ok ? a : (unsigned short)0; R.k[x] = ok ? b : (unsigned short)0; R.v[x] = ok ? cc : (unsigned short)0; }
#pragma unroll
    for (int i = 0; i < 4; ++i) { const size_t off = (size_t)(seqbase + tau0 + i) * D + X.c; R.lam[i] = X.lamd[off]; R.av[i] = X.avd[off]; }
}
__device__ __forceinline__ void scan_put(const ScanCtx& X, int seqbase, int lo, const ScanRaw& R, float* buf) {
#pragma unroll
    for (int i = 0; i < 4; ++i) {
        const float r0 = bf1(R.r[i]), r1 = bf1(R.r[i + 1]), r2 = bf1(R.r[i + 2]), k0 = bf1(R.k[i]), k1 = bf1(R.k[i + 1]), k2 = bf1(R.k[i + 2]), v0 = bf1(R.v[i]), v1 = bf1(R.v[i + 1]), v2 = bf1(R.v[i + 2]);
        const float rs = r1 + X.mpr * (r0 - r1) + X.mnr * (r2 - r1), ks = k1 + X.mpk * (k0 - k1) + X.mnk * (k2 - k1), vs = v1 + X.mpv * (v0 - v1) + X.mnv * (v2 - v1);
        const float kkr = ks * X.kkc, ss = wave_sum_u(kkr * kkr), kk = kkr * __builtin_amdgcn_rsqf(fmaxf(ss, 1e-24f));
        const float a = __half2float(R.av[i]), w = __builtin_amdgcn_exp2f(-1.44269504f * __half2float(R.lam[i])), kd = ks * (1.f + (a - 1.f) * X.kac), b = kk * a;
        const float bon = wave_sum_u(rs * kd * X.rkc);
        const int ti = 4 * X.wq + i;
        X.bs[(size_t)(seqbase + lo + ti) * 32 + X.h] = bon;
        const int slot = X.dir ? CT - 1 - ti : ti;
        float* o = buf + slot * 384 + X.lane;
        o[0] = w; o[64] = b; o[128] = kd; o[192] = rs; o[256] = -kk; o[320] = vs;
    }
}
struct StepOps { f32x4 w0, w1, b0, b1, k0, k1, r0, r1, a0, a1; f32x2 v; };
__device__ __forceinline__ StepOps step_load(const float* o  , const float* vv  , int s) {
    StepOps P; const float* x = o + s * 384;
    P.w0 = *(const f32x4*)(x); P.w1 = *(const f32x4*)(x + 4); P.b0 = *(const f32x4*)(x + 64); P.b1 = *(const f32x4*)(x + 68); P.k0 = *(const f32x4*)(x + 128); P.k1 = *(const f32x4*)(x + 132);
    P.r0 = *(const f32x4*)(x + 192); P.r1 = *(const f32x4*)(x + 196); P.a0 = *(const f32x4*)(x + 256); P.a1 = *(const f32x4*)(x + 260); P.v = *(const f32x2*)(vv + s * 384);
    return P;
}
#define PKFMA(a, b, c) __builtin_elementwise_fma((a), (b), (c))
__device__ __forceinline__ void scan_steps8(const float* buf, f32x2 (&S)[2][4], float* yrow, int lo, int dir, int q, int il, int wq) {
    const float* o = buf + 8 * q; const float* vv = buf + 320 + 16 * wq + 2 * il;
    f32x2 ysel = {0.f, 0.f};
    StepOps cur = step_load(o, vv, 0);
#pragma unroll
    for (int s = 0; s < 8; ++s) {
        StepOps nxt = cur;
        if (s < 7) nxt = step_load(o, vv, s + 1);
        const f32x2 ap[4] = {cur.a0.xy, cur.a0.zw, cur.a1.xy, cur.a1.zw}, wp[4] = {cur.w0.xy, cur.w0.zw, cur.w1.xy, cur.w1.zw}, bp[4] = {cur.b0.xy, cur.b0.zw, cur.b1.xy, cur.b1.zw},
                    kp[4] = {cur.k0.xy, cur.k0.zw, cur.k1.xy, cur.k1.zw}, rp[4] = {cur.r0.xy, cur.r0.zw, cur.r1.xy, cur.r1.zw};
        float yy[2];
#pragma unroll
        for (int rr = 0; rr < 2; ++rr) {
            f32x2 pa = S[rr][0] * ap[0];
#pragma unroll
            for (int j = 1; j < 4; ++j) pa = PKFMA(S[rr][j], ap[j], pa);
            const float sa = oct_sum(pa.x + pa.y);
            const f32x2 sav = {sa, sa}, vb = {cur.v[rr], cur.v[rr]};
            f32x2 py;
#pragma unroll
            for (int j = 0; j < 4; ++j) { const f32x2 t = PKFMA(sav, bp[j], vb * kp[j]); S[rr][j] = PKFMA(S[rr][j], wp[j], t); py = j == 0 ? S[rr][j] * rp[j] : PKFMA(S[rr][j], rp[j], py); }
            yy[rr] = oct_sum(py.x + py.y);
        }
        ysel.x = (q == s) ? yy[0] : ysel.x; ysel.y = (q == s) ? yy[1] : ysel.y;
        cur = nxt;
    }
    const int tau = dir ? lo + 7 - q : lo + q;
    *(f32x2*)(yrow + (size_t)tau * D + 16 * wq + 2 * il) = ysel;
}
__device__ __forceinline__ void scan_pos(int bb, int grp, int dir, int gck, int& seqbase, int& L, int& lo) {
    if (grp == 0) { seqbase = NCTX + (bb >> 6) * 1024; L = 1024; lo = dir ? 1024 - CT - CT * gck : CT * gck; }
    else { const int m = gck >> 4, lc = gck & 15; seqbase = ((bb >> 6) + 4 * m) * 256; L = 256; lo = dir ? 256 - CT - CT * lc : CT * lc; }
}
__device__ __forceinline__ void p4_scan(const Params& p, float* ldsf) {
    const int tid = threadIdx.x, lane = tid & 63, wave = tid >> 6, G = gridDim.x, q = lane & 7, il = lane >> 3, grp = wave >> 2, wq = wave & 3, row0 = 16 * wq + 2 * il;
    float* gbuf = ldsf + grp * (2 * CBUF);
    for (int bb = blockIdx.x; bb < 256; bb += G) {
        const int h = (bb >> 1) & 31, dir = bb & 1;
        ScanCtx X;
        X.zr = (const bf16_t*)(p.ws + OFF_ZR); X.zk = X.zr + GS; X.zv = X.zk + GS;
        X.lamd = (const __half*)(p.ws + OFF_LAM) + (size_t)dir * GS; X.avd = X.lamd + 2 * GS; X.bs = (float*)(p.ws + OFF_BS) + (size_t)dir * NTOK * 32;
        X.h = h; X.dir = dir; X.lane = lane; X.wq = wq; X.c = h * 64 + lane;
        X.mpr = p.mu_prev[X.c]; X.mnr = p.mu_next[X.c]; X.mpk = p.mu_prev[2048 + X.c]; X.mnk = p.mu_next[2048 + X.c]; X.mpv = p.mu_prev[4096 + X.c]; X.mnv = p.mu_next[4096 + X.c];
        X.kkc = p.k_k[X.c]; X.kac = p.k_a[X.c]; X.rkc = p.r_k[X.c];
        f32x2 S[2][4];
        if (grp == 0) { const float* s0 = (dir ? p.st_b : p.st_f) + ((size_t)((bb >> 6) * 32 + h) * 64 + row0) * 64 + 8 * q;
#pragma unroll
            for (int rr = 0; rr < 2; ++rr) { const f32x4 x0 = *(const f32x4*)(s0 + rr * 64), x1 = *(const f32x4*)(s0 + rr * 64 + 4); S[rr][0] = x0.xy; S[rr][1] = x0.zw; S[rr][2] = x1.xy; S[rr][3] = x1.zw; } }
        else {
#pragma unroll
            for (int rr = 0; rr < 2; ++rr)
#pragma unroll
                for (int j = 0; j < 4; ++j) S[rr][j] = (f32x2){0.f, 0.f}; }
        float* ybase = (float*)(p.ws + OFF_YDIR) + (size_t)dir * GS + h * 64;
        float* sbase = p.out + GS + (size_t)dir * (16 * 32 * 4096);
        ScanRaw R; int sb, L, lo;
        __syncthreads();
        scan_pos(bb, grp, dir, 0, sb, L, lo); scan_load(X, sb, L, lo, R); scan_put(X, sb, lo, R, gbuf);
        scan_pos(bb, grp, dir, 1, sb, L, lo); scan_load(X, sb, L, lo, R);
        __syncthreads();
#pragma unroll 1
        for (int gck = 0; gck < 64; ++gck) {
            if (gck + 1 < 64) { scan_pos(bb, grp, dir, gck + 1, sb, L, lo); scan_put(X, sb, lo, R, gbuf + ((gck + 1) & 1) * CBUF); }
            if (gck + 2 < 64) { scan_pos(bb, grp, dir, gck + 2, sb, L, lo); scan_load(X, sb, L, lo, R); }
            scan_pos(bb, grp, dir, gck, sb, L, lo);
            const float* cb = gbuf + (gck & 1) * CBUF; float* yrow = ybase + (size_t)sb * D;
            scan_steps8(cb, S, yrow, dir ? lo + 8 : lo, dir, q, il, wq);
            scan_steps8(cb + 8 * 384, S, yrow, dir ? lo : lo + 8, dir, q, il, wq);
            if (grp == 1 && (gck & 15) == 15) {
                float* so = sbase + ((size_t)((sb >> 8) * 32 + h) * 64 + row0) * 64 + 8 * q;
#pragma unroll
                for (int rr = 0; rr < 2; ++rr) { f32x4 x0, x1; x0.xy = S[rr][0]; x0.zw = S[rr][1]; x1.xy = S[rr][2]; x1.zw = S[rr][3]; *(f32x4*)(so + rr * 64) = x0; *(f32x4*)(so + rr * 64 + 4) = x1;
#pragma unroll
                    for (int j = 0; j < 4; ++j) S[rr][j] = (f32x2){0.f, 0.f}; } }
            __syncthreads();
        }
    }
}

__device__ __forceinline__ void p5_gn(const Params& p) {
    const int tid = threadIdx.x, G = gridDim.x;
    const float* y0p = (const float*)(p.ws + OFF_YDIR); const float* y1p = y0p + GS;
    const float* bs0 = (const float*)(p.ws + OFF_BS); const float* bs1 = bs0 + (size_t)NTOK * 32;
    const bf16_t* zv = (const bf16_t*)(p.ws + OFF_ZR) + 2 * GS; const bf16_t* zga = (const bf16_t*)(p.ws + OFF_ZG);
    bf16_t* ya = (bf16_t*)(p.ws + OFF_WINT);
    for (int i = blockIdx.x * 512 + tid; i < NTOK * 512; i += G * 512) {
        const int t = i >> 9, c = (i & 511) * 4, h = c >> 6;
        const size_t o = (size_t)t * D + c;
        const f32x4 y = *(const f32x4*)(y0p + o) + *(const f32x4*)(y1p + o);
        float s = (y.x + y.y) + (y.z + y.w);
        s += __shfl_xor(s, 1); s += __shfl_xor(s, 2); s += __shfl_xor(s, 4); s += __shfl_xor(s, 8);
        const float mu = s * (1.f / 64.f); const f32x4 d = y - mu;
        float s2 = (d.x * d.x + d.y * d.y) + (d.z * d.z + d.w * d.w);
        s2 += __shfl_xor(s2, 1); s2 += __shfl_xor(s2, 2); s2 += __shfl_xor(s2, 4); s2 += __shfl_xor(s2, 8);
        const float rstd = rsqrtf(s2 * (1.f / 64.f) + 64e-5f);
        const int L = t < NCTX ? 256 : 1024, tau = t & (L - 1);
        const u32x2 vc = *(const u32x2*)(zv + o); u32x2 vp = {0u, 0u}, vn = {0u, 0u};
        if (tau != 0) vp = *(const u32x2*)(zv + o - D);
        if (tau != L - 1) vn = *(const u32x2*)(zv + o + D);
        const f32x4 fc = {bflo(vc.x), bfhi(vc.x), bflo(vc.y), bfhi(vc.y)}, fp = {bflo(vp.x), bfhi(vp.x), bflo(vp.y), bfhi(vp.y)}, fn = {bflo(vn.x), bfhi(vn.x), bflo(vn.y), bfhi(vn.y)};
        const f32x4 mp = *(const f32x4*)(p.mu_prev + 4096 + c), mn = *(const f32x4*)(p.mu_next + 4096 + c);
        const f32x4 vs = fc + mp * (fp - fc) + mn * (fn - fc);
        const float bon = bs0[(size_t)t * 32 + h] + bs1[(size_t)t * 32 + h];
        const f32x4 lg = *(const f32x4*)(p.lnx_g + c), lb = *(const f32x4*)(p.lnx_b + c);
        const u32x2 gu = *(const u32x2*)(zga + o); const f32x4 ga = {bflo(gu.x), bfhi(gu.x), bflo(gu.y), bfhi(gu.y)};
        f32x4 r = (d * rstd) * lg + lb + bon * vs;
#pragma unroll
        for (int j = 0; j < 4; ++j) r[j] *= ga[j] / (1.f + __expf(-ga[j]));
        u32x2 w; w.x = pk2(r[0], r[1]); w.y = pk2(r[2], r[3]);
        *(u32x2*)(ya + o) = w;
    }
}

__device__ __forceinline__ void p8_final(const Params& p) {
    const int tid = threadIdx.x, lane = tid & 63, wave = tid >> 6, G = gridDim.x;
    for (int t = blockIdx.x * 8 + wave; t < NTOK; t += G * 8) {
        float* xr = p.out + (size_t)t * D;
        f32x4 v[8]; float ss = 0.f;
#pragma unroll
        for (int j = 0; j < 8; ++j) { v[j] = *(const f32x4*)(xr + 4 * lane + 256 * j); ss += (v[j].x * v[j].x + v[j].y * v[j].y) + (v[j].z * v[j].z + v[j].w * v[j].w); }
        const float rstd = rsqrtf(wave_sum(ss) * (1.f / D) + 1e-6f);
#pragma unroll
        for (int j = 0; j < 8; ++j) { const int c = 4 * lane + 256 * j; const f32x4 g = *(const f32x4*)(p.final_g + c); *(f32x4*)(xr + c) = (v[j] * rstd) * g; }
    }
}

__global__ void __launch_bounds__(512, 2) mega(Params p) {
    extern __shared__ __attribute__((aligned(16))) unsigned char shm[];
    float* ldsf = (float*)shm;
    cg::grid_group grid = cg::this_grid();
    const int lo = p.ph_lo, hi = p.ph_hi;
    if (lo == 0) { for (int rep = 0; rep < ((DUP_MASK & 1) ? 2 : 1); ++rep) p0_prep(p, ldsf); }
#define PHASE_BEGIN(k) if (lo <= (k) && (k) < hi) { if ((k) > lo) grid.sync(); const Params& q = p; for (int rep = 0; rep < (((DUP_MASK >> (k)) & 1) ? 2 : 1); ++rep) {
#define PHASE_END } }
    PHASE_BEGIN(1) p1_norm(q, ldsf); PHASE_END
    PHASE_BEGIN(2) pg8::Gemm g{(const bf16_t*)(q.ws + OFF_H), (const bf16_t*)(q.ws + OFF_WINT), NTOK, NPAD, D}; pg8::StaticOrder S; S.init(NTOK, NPAD, gridDim.x, blockIdx.x); pg8::EpiZ E{q.ws};
        pg8::gemm_phase((LAS unsigned char*)shm, g, S, E); PHASE_END
    PHASE_BEGIN(3) p3_lora_conv(q); PHASE_END
    PHASE_BEGIN(4) p4_scan(q, ldsf); PHASE_END
    PHASE_BEGIN(5) p5_gn(q); PHASE_END
    PHASE_BEGIN(6) pg8::Gemm g{(const bf16_t*)(q.ws + OFF_WINT), (const bf16_t*)(q.ws + OFF_WABT), NTOK, D, D}; pg8::PairOrder S; S.init(NTOK, D, gridDim.x, blockIdx.x);
        pg8::EpiMerge E{(const bf16_t*)(q.ws + OFF_ZG) + 5 * GS, (const bf16_t*)(q.ws + OFF_ZG) + 6 * GS, (bf16_t*)(q.ws + OFF_H)};
        pg8::gemm_phase((LAS unsigned char*)shm, g, S, E); PHASE_END
    PHASE_BEGIN(7) pg8::Gemm g{(const bf16_t*)(q.ws + OFF_H), (const bf16_t*)(q.ws + OFF_WOT), NTOK, D, D}; pg8::StaticOrder S; S.init(NTOK, D, gridDim.x, blockIdx.x);
        pg8::EpiOut E{q.xp, q.xs, (const float*)(q.ws + OFF_MODG), q.out};
        pg8::gemm_phase((LAS unsigned char*)shm, g, S, E); PHASE_END
    PHASE_BEGIN(8) p8_final(q); PHASE_END
}

constexpr int LDS_BYTES = 128 * 1024;

extern "C" void kernel_launch(void* const* d_in, const int* in_sizes, int n_in, void* d_out, int out_size, void* d_ws, size_t ws_size, hipStream_t stream) {
    static int grid = 0;
    if (grid == 0) {
        if (n_in != 26 || ws_size < WS_END) { fprintf(stderr, "kernel_launch: need 26 inputs and %zu bytes of workspace; got %d, %zu\n", (size_t)WS_END, n_in, ws_size); grid = -1; return; }
        int dev = 0, cus = 0, per_cu = 0;
        (void)hipGetDevice(&dev); (void)hipDeviceGetAttribute(&cus, hipDeviceAttributeMultiprocessorCount, dev);
        if (hipFuncSetAttribute((const void*)mega, hipFuncAttributeMaxDynamicSharedMemorySize, LDS_BYTES) != hipSuccess) { fprintf(stderr, "kernel_launch: hipFuncSetAttribute failed\n"); grid = -1; return; }
        if (hipOccupancyMaxActiveBlocksPerMultiprocessor(&per_cu, (const void*)mega, 512, LDS_BYTES) != hipSuccess || per_cu < 1) { fprintf(stderr, "kernel_launch: occupancy query failed (%d)\n", per_cu); (void)hipGetLastError(); per_cu = 1; }
        if (per_cu > 1) per_cu = 1;
        grid = cus * per_cu;
    }
    if (grid < 0) return;
    Params p{};
    const float** pp = (const float**)&p;
    for (int i = 0; i < 26; ++i) pp[i] = (const float*)d_in[i];
    p.out = (float*)d_out; p.ws = (unsigned char*)d_ws;
#if N_LAUNCH_SPLIT
    for (int ph = 0; ph < NPHASE; ++ph) { p.ph_lo = ph; p.ph_hi = ph + 1; hipLaunchKernelGGL(mega, dim3(grid), dim3(512), LDS_BYTES, stream, p); }
#else
    p.ph_lo = 0; p.ph_hi = PH_HI;
    void* args[] = {&p};
    hipError_t e = hipLaunchCooperativeKernel((const void*)mega, dim3(grid), dim3(512), args, LDS_BYTES, stream);
    if (e != hipSuccess) fprintf(stderr, "cooperative launch failed: %s (grid %d)\n", hipGetErrorString(e), grid);
#endif
}
```
